# Optimizing an MI355X kernel written in HIP

```python
import math
import jax, jax.numpy as jnp
from jax import lax
import numpy as np

D_MODEL = 1024
BATCH = 4
SEQ = 4096
DEPTH = 2

CHUNK = 64
Q_BLOCK = 128
HEAD_DIM = 64
N_HEADS_DIFF = 4
DIFF_V_DIM = 2 * HEAD_DIM
N_HEADS_SB = 8
N_HEADS_FOX = 8
W_DIFF = N_HEADS_DIFF * DIFF_V_DIM
W_SB = N_HEADS_SB * HEAD_DIM
W_FOX = N_HEADS_FOX * HEAD_DIM
D_MIX = W_DIFF + W_SB + W_FOX
ROT_DIM = HEAD_DIM // 4
ROPE_THETA = 500000.0
NORM_EPS = 1e-6
IN_SPLITS = [W_DIFF, W_DIFF, W_DIFF, W_DIFF,
             W_SB, W_SB, W_SB, W_SB,
             W_FOX, W_FOX, W_FOX, W_FOX,
             N_HEADS_FOX]
D_IN = sum(IN_SPLITS)

kernel_name = "hybrid_diff_stickbreak_fox_block"


def rms_norm(x, gain):
    xf = x.astype(jnp.float32)
    y = xf * lax.rsqrt(jnp.mean(xf * xf, axis=-1, keepdims=True) + NORM_EPS)
    return (y * gain.astype(jnp.float32)).astype(x.dtype)


def rope_tables(seq):
    pos = jnp.arange(seq, dtype=jnp.float32)
    inv_freq = ROPE_THETA ** (-jnp.arange(0, ROT_DIM, 2, dtype=jnp.float32) / ROT_DIM)
    ang = pos[:, None] * inv_freq[None, :]
    return jnp.cos(ang), jnp.sin(ang)


def apply_partial_rope(t, cos, sin):
    rot, rest = t[..., :ROT_DIM], t[..., ROT_DIM:]
    r1, r2 = rot[..., :ROT_DIM // 2], rot[..., ROT_DIM // 2:]
    rot = jnp.concatenate([r1 * cos - r2 * sin, r2 * cos + r1 * sin], axis=-1).astype(t.dtype)
    return jnp.concatenate([rot, rest], axis=-1)


def diff_attention(q, k, v, lam, lambda_init, sub_gain):
    seq = q.shape[3]
    scale = q.shape[-1] ** -0.5
    chunk_id = jnp.arange(seq) // CHUNK
    outs = []
    for i in range(seq // Q_BLOCK):
        q0, q1 = i * Q_BLOCK, (i + 1) * Q_BLOCK
        s = jnp.einsum('bhcqd,bhckd->bhcqk', q[:, :, :, q0:q1], k[:, :, :, :q1]).astype(jnp.float32) * scale
        allowed = chunk_id[:q1][None, :] <= chunk_id[q0:q1][:, None]
        p = jax.nn.softmax(jnp.where(allowed, s, -jnp.inf), axis=-1)
        w = p[:, :, 0] - lam * p[:, :, 1]
        outs.append(jnp.einsum('bhqk,bhkd->bhqd', w, v[:, :, :q1].astype(jnp.float32)))
    o = jnp.concatenate(outs, axis=2)
    return rms_norm(o, sub_gain) * (1.0 - lambda_init)


def stick_breaking_attention(q, k, v):
    seq = q.shape[2]
    scale = q.shape[-1] ** -0.5
    pos = jnp.arange(seq)
    outs = []
    for i in range(seq // Q_BLOCK):
        q0, q1 = i * Q_BLOCK, (i + 1) * Q_BLOCK
        z = jnp.einsum('bhqd,bhkd->bhqk', q[:, :, q0:q1], k[:, :, :q1]).astype(jnp.float32) * scale
        strict = pos[:q1][None, :] < pos[q0:q1][:, None]
        log_keep = jnp.where(strict, jax.nn.log_sigmoid(-z), 0.0)
        log_rest = lax.cumsum(log_keep, axis=3, reverse=True) - log_keep
        a = jnp.where(strict, jnp.exp(jax.nn.log_sigmoid(z) + log_rest), 0.0)
        outs.append(jnp.einsum('bhqk,bhkd->bhqd', a, v[:, :, :q1].astype(jnp.float32)))
    return jnp.concatenate(outs, axis=2)


def forgetting_attention(q, k, v, cum_log_f):
    seq = q.shape[2]
    scale = q.shape[-1] ** -0.5
    pos = jnp.arange(seq)
    outs = []
    for i in range(seq // Q_BLOCK):
        q0, q1 = i * Q_BLOCK, (i + 1) * Q_BLOCK
        logits = jnp.einsum('bhqd,bhkd->bhqk', q[:, :, q0:q1], k[:, :, :q1]).astype(jnp.float32) * scale
        logits = logits + cum_log_f[:, :, q0:q1, None] - cum_log_f[:, :, None, :q1]
        causal = pos[:q1][None, :] <= pos[q0:q1][:, None]
        p = jax.nn.softmax(jnp.where(causal, logits, -jnp.inf), axis=-1)
        outs.append(jnp.einsum('bhqk,bhkd->bhqd', p, v[:, :, :q1].astype(jnp.float32)))
    return jnp.concatenate(outs, axis=2)


def hybrid_layer(x, w_in, f_bias, lam_vec, subln, w_out, g_pre, g_post, layer_idx, cos, sin):
    b, s, _ = x.shape
    dt = x.dtype
    h = rms_norm(x, g_pre)
    p = h @ w_in
    split_at = np.cumsum(IN_SPLITS)[:-1].tolist()
    qa, ka, va, ga, qs, ks, vs, gs, qf, kf, vf, gf, ff = jnp.split(p, split_at, axis=-1)

    def heads(t, n, d):
        return t.reshape(b, s, n, d).transpose(0, 2, 1, 3)

    def merge(t):
        return t.transpose(0, 2, 1, 3).reshape(b, s, -1).astype(dt)

    qa = apply_partial_rope(qa.reshape(b, s, N_HEADS_DIFF, 2, HEAD_DIM).transpose(0, 2, 3, 1, 4), cos, sin)
    ka = apply_partial_rope(ka.reshape(b, s, N_HEADS_DIFF, 2, HEAD_DIM).transpose(0, 2, 3, 1, 4), cos, sin)
    lambda_init = 0.8 - 0.6 * math.exp(-0.3 * layer_idx)
    lv = lam_vec.astype(jnp.float32)
    lam = jnp.exp(jnp.sum(lv[0] * lv[1])) - jnp.exp(jnp.sum(lv[2] * lv[3])) + lambda_init
    ya = merge(diff_attention(qa, ka, heads(va, N_HEADS_DIFF, DIFF_V_DIM), lam, lambda_init, subln))
    ya = ya * jax.nn.silu(ga)

    yb = merge(stick_breaking_attention(heads(qs, N_HEADS_SB, HEAD_DIM), heads(ks, N_HEADS_SB, HEAD_DIM),
                                        heads(vs, N_HEADS_SB, HEAD_DIM)))
    yb = yb * jax.nn.silu(gs)

    log_f = jax.nn.log_sigmoid((ff + f_bias).astype(jnp.float32)).transpose(0, 2, 1)
    cum_log_f = jnp.cumsum(log_f, axis=-1)
    yc = merge(forgetting_attention(heads(qf, N_HEADS_FOX, HEAD_DIM), heads(kf, N_HEADS_FOX, HEAD_DIM),
                                    heads(vf, N_HEADS_FOX, HEAD_DIM), cum_log_f))
    yc = yc * jax.nn.silu(gf)

    y = jnp.concatenate([ya, yb, yc], axis=-1) @ w_out
    return x + rms_norm(y, g_post)


def setup_inputs(seed: int = 0) -> dict:
    key = jax.random.key(seed)
    ks = jax.random.split(key, 8)
    x = jax.random.normal(ks[0], (BATCH, SEQ, D_MODEL), jnp.float32)
    w_in = jax.random.normal(ks[1], (DEPTH, D_MODEL, D_IN), jnp.float32) * D_MODEL ** -0.5
    forget_bias = jax.random.uniform(ks[2], (DEPTH, N_HEADS_FOX), jnp.float32, minval=1.0, maxval=4.0)
    diff_lambda = 0.1 * jax.random.normal(ks[3], (DEPTH, 4, HEAD_DIM), jnp.float32)
    diff_subln = 1.0 + 0.02 * jax.random.normal(ks[4], (DEPTH, DIFF_V_DIM), jnp.float32)
    w_out = jax.random.normal(ks[5], (DEPTH, D_MIX, D_MODEL), jnp.float32) * D_MIX ** -0.5
    pre_norm = 1.0 + 0.02 * jax.random.normal(ks[6], (DEPTH, D_MODEL), jnp.float32)
    post_norm = 1.0 + 0.02 * jax.random.normal(ks[7], (DEPTH, D_MODEL), jnp.float32)
    return {"x": x, "w_in": w_in, "forget_bias": forget_bias, "diff_lambda": diff_lambda,
            "diff_subln": diff_subln, "w_out": w_out, "pre_norm": pre_norm, "post_norm": post_norm}


def reference(x, w_in, forget_bias, diff_lambda, diff_subln, w_out, pre_norm, post_norm):
    cos, sin = rope_tables(x.shape[1])
    for l in range(DEPTH):
        x = hybrid_layer(x, w_in[l], forget_bias[l], diff_lambda[l], diff_subln[l], w_out[l],
                         pre_norm[l], post_norm[l], l, cos, sin)
    return x
```

```cpp
#include <hip/hip_runtime.h>
#include <hip/hip_cooperative_groups.h>
#include <cstdio>
namespace cg = cooperative_groups;

#ifndef EXP_VAR
#define EXP_VAR 0
#endif
#ifndef DUP_PHASE
#define DUP_PHASE -1
#endif

typedef unsigned short bf16_t;
typedef short bf16x8 __attribute__((ext_vector_type(8)));
typedef float f32x16 __attribute__((ext_vector_type(16)));
typedef float f32x4 __attribute__((ext_vector_type(4)));
typedef float f32x2 __attribute__((ext_vector_type(2)));
typedef __bf16 bf16x2n __attribute__((ext_vector_type(2)));
typedef unsigned u32x2 __attribute__((ext_vector_type(2)));
typedef unsigned u32x4 __attribute__((ext_vector_type(4)));

#define DI __device__ __forceinline__
#define MFMA32(a, b, c) __builtin_amdgcn_mfma_f32_32x32x16_bf16((a), (b), (c), 0, 0, 0)

constexpr int T = 16384, S = 4096, D = 1024, DIN = 6152, DMIX = 1536;
constexpr int LROW = 72;
constexpr float LOG2E = 1.4426950408889634f;
constexpr float NORM_EPS = 1e-6f;
constexpr int SMEM_BYTES = 73728;

constexpr size_t OFF_WINT = 0;
constexpr size_t OFF_WOUTT = OFF_WINT + (size_t)6144 * 1024 * 2;
constexpr size_t OFF_H = OFF_WOUTT + (size_t)2 * 1024 * 1536 * 2;
constexpr size_t OFF_QKV = OFF_H + (size_t)T * 1024 * 2;
constexpr size_t TENS = (size_t)T * 512;
constexpr size_t OFF_G = OFF_QKV + 9 * TENS * 2;
constexpr size_t OFF_LF = OFF_G + (size_t)T * 1536 * 2;
constexpr size_t OFF_CUM = OFF_LF + (size_t)32 * 4096 * 4;
constexpr size_t OFF_ROPE = OFF_CUM + (size_t)32 * 4096 * 4;
constexpr size_t OFF_CTR = OFF_ROPE + (size_t)2 * 4096 * 8 * 4;
constexpr size_t OFF_KMAX = OFF_CTR + 1024;
constexpr size_t OFF_BAR = OFF_CTR + 4096;
constexpr size_t WS_NEED = OFF_BAR + 16384;

struct Params {
  const float* x; const float* w_in; const float* fbias; const float* dlam; const float* subln;
  const float* w_out; const float* gpre; const float* gpost; float* out; unsigned char* ws;
};

DI int tid_opaque() { int t = threadIdx.x; asm volatile("" : "+v"(t)); return t; }
DI int bid_opaque() { int b = blockIdx.x; asm volatile("" : "+s"(b)); return b; }
DI unsigned pk2(float a, float b) { f32x2 v = {a, b}; bf16x2n r = __builtin_convertvector(v, bf16x2n); return __builtin_bit_cast(unsigned, r); }
DI float bflo(unsigned u) { return __uint_as_float(u << 16); }
DI float bfhi(unsigned u) { return __uint_as_float(u & 0xffff0000u); }
DI float wave_sum(float v) {
#pragma unroll
  for (int o = 32; o; o >>= 1) v += __shfl_xor(v, o);
  return v;
}
DI float xhalf(float v) { return __shfl_xor(v, 32); }
DI float xmax(float v) {
  auto r = __builtin_amdgcn_permlane32_swap(__float_as_uint(v), __float_as_uint(v), false, false);
  return fmaxf(__uint_as_float(r[0]), __uint_as_float(r[1]));
}
DI float xsum(float v) {
  auto r = __builtin_amdgcn_permlane32_swap(__float_as_uint(v), __float_as_uint(v), false, false);
  return __uint_as_float(r[0]) + __uint_as_float(r[1]);
}
DI void xboth(float v, float& lo, float& hi) {
  auto r = __builtin_amdgcn_permlane32_swap(__float_as_uint(v), __float_as_uint(v), false, false);
  lo = __uint_as_float(r[0]); hi = __uint_as_float(r[1]);
}
DI u32x4 swap_pair(u32x2 pe, u32x2 po) {
  auto r0 = __builtin_amdgcn_permlane32_swap(pe[0], po[0], false, false);
  auto r1 = __builtin_amdgcn_permlane32_swap(pe[1], po[1], false, false);
  u32x4 o = {r0[0], r1[0], r0[1], r1[1]};
  return o;
}
DI bf16x8 pack8(float a0, float a1, float a2, float a3, float a4, float a5, float a6, float a7) {
  u32x4 u = {pk2(a0, a1), pk2(a2, a3), pk2(a4, a5), pk2(a6, a7)};
  return __builtin_bit_cast(bf16x8, u);
}
DI float log_sigmoid_f(float v) { return fminf(v, 0.f) - __logf(1.f + __expf(-fabsf(v))); }

DI void transpose_tile(const float* __restrict__ src, int ldn, bf16_t* __restrict__ dst, int K, int k0, int n0, char* smem) {
  float* tile = (float*)smem;
  const int t = tid_opaque();
#pragma unroll
  for (int p = 0; p < 16; ++p) {
    const int k = p * 4 + (t >> 6), n = t & 63;
    tile[k * 65 + n] = src[(size_t)(k0 + k) * ldn + n0 + n];
  }
  __syncthreads();
#pragma unroll
  for (int p = 0; p < 8; ++p) {
    const int n = p * 8 + (t >> 5), k = (t & 31) * 2;
    *(unsigned*)(dst + (size_t)(n0 + n) * K + k0 + k) = pk2(tile[k * 65 + n], tile[(k + 1) * 65 + n]);
  }
  __syncthreads();
}

DI void stage_wf(const float* __restrict__ w_in_l, char* smem) {
  float* wf = (float*)smem;
  const int t0 = tid_opaque();
  for (int e = t0; e < 2048; e += 256) {
    const int k = e >> 1, half = e & 1;
    const f32x4 v = *(const f32x4*)(w_in_l + (size_t)k * DIN + 6144 + half * 4);
#pragma unroll
    for (int i = 0; i < 4; ++i) wf[(half * 4 + i) * 1024 + k] = v[i];
  }
  __syncthreads();
}

DI void prenorm_row(const f32x4 (&xv)[4], const float* __restrict__ gpre, const float* wf, const float* __restrict__ fbias,
                    bf16_t* __restrict__ hbuf, float* __restrict__ lf, int tok, int lane) {
  float ss = 0.f;
#pragma unroll
  for (int p = 0; p < 4; ++p)
#pragma unroll
    for (int i = 0; i < 4; ++i) ss += xv[p][i] * xv[p][i];
  ss = wave_sum(ss);
  const float rinv = rsqrtf(ss * (1.f / 1024.f) + NORM_EPS);
  float ff[8];
#pragma unroll
  for (int hh = 0; hh < 8; ++hh) ff[hh] = 0.f;
#pragma unroll
  for (int p = 0; p < 4; ++p) {
    const f32x4 g = *(const f32x4*)(gpre + 256 * p + 4 * lane);
    f32x4 hv;
#pragma unroll
    for (int i = 0; i < 4; ++i) hv[i] = xv[p][i] * rinv * g[i];
    u32x2 st = {pk2(hv[0], hv[1]), pk2(hv[2], hv[3])};
    *(u32x2*)(hbuf + (size_t)tok * 1024 + 256 * p + 4 * lane) = st;
#pragma unroll
    for (int hh = 0; hh < 8; ++hh) {
      const f32x4 w = *(const f32x4*)(wf + hh * 1024 + 256 * p + 4 * lane);
      ff[hh] += hv[0] * w[0] + hv[1] * w[1] + hv[2] * w[2] + hv[3] * w[3];
    }
    __builtin_amdgcn_sched_barrier(0);
  }
  float mine = 0.f;
#pragma unroll
  for (int hh = 0; hh < 8; ++hh) {
    const float s = wave_sum(ff[hh]);
    if (lane == hh) mine = s;
  }
  if (lane < 8) lf[((size_t)(tok >> 12) * 8 + lane) * 4096 + (tok & 4095)] = log_sigmoid_f(mine + fbias[lane]);
}

DI void cumsum_item(const float* __restrict__ lf, float* __restrict__ cum, int seq, char* smem) {
  float* sm = (float*)smem;
  const int t = tid_opaque(), lane = t & 63, w = t >> 6;
  float v[16];
#pragma unroll
  for (int p = 0; p < 4; ++p) {
    const f32x4 a = *(const f32x4*)(lf + (size_t)seq * 4096 + 16 * t + 4 * p);
#pragma unroll
    for (int i = 0; i < 4; ++i) v[4 * p + i] = a[i];
  }
#pragma unroll
  for (int i = 1; i < 16; ++i) v[i] += v[i - 1];
  float tot = v[15];
  float inc = tot;
#pragma unroll
  for (int o = 1; o < 64; o <<= 1) { const float n = __shfl_up(inc, o); if (lane >= o) inc += n; }
  if (lane == 63) sm[w] = inc;
  __syncthreads();
  float base = inc - tot;
  for (int i = 0; i < w; ++i) base += sm[i];
#pragma unroll
  for (int p = 0; p < 4; ++p) {
    f32x4 a;
#pragma unroll
    for (int i = 0; i < 4; ++i) a[i] = (v[4 * p + i] + base) * LOG2E;
    *(f32x4*)(cum + (size_t)seq * 4096 + 16 * t + 4 * p) = a;
  }
  __syncthreads();
}

constexpr int GA_BYTES = 256 * 64, GB_BYTES = 128 * 64, GSTAGE = GA_BYTES + GB_BYTES;
typedef __attribute__((address_space(3))) void* lds_vp;
typedef const __attribute__((address_space(1))) void* glb_vp;
DI void glds16(const char* g, char* lds_wave_base) {
  __builtin_amdgcn_global_load_lds((glb_vp)(unsigned long long)g, (lds_vp)(unsigned)(unsigned long long)lds_wave_base, 16, 0, 0);
}
template <bool TR>
DI void gemm_mainloop(const int t, const bf16_t* __restrict__ A, int lda, const bf16_t* __restrict__ B, int ldb, int K, char* smem, f32x16 (&acc)[4][2], const int var = 0) {
  const int lane = t & 63, w = t >> 6, wm = w >> 1, wn = w & 1, r = lane & 31, h = lane >> 5;
  const int wu = __builtin_amdgcn_readfirstlane(w);
  const int srow = lane >> 2, schunk = (lane & 3) ^ ((lane >> 4) & 3);
  unsigned aoff[4], boff[2];
#pragma unroll
  for (int p = 0; p < 4; ++p) aoff[p] = (unsigned)((((p * 4 + wu) * 16 + srow) * lda + schunk * 8) * 2);
#pragma unroll
  for (int p = 0; p < 2; ++p) boff[p] = (unsigned)((((p * 4 + wu) * 16 + srow) * ldb + schunk * 8) * 2);
  const char* Ab = (const char*)A;
  const char* Bb = (const char*)B;
  char* dA = smem + wu * 1024;
  char* dB = smem + GA_BYTES + wu * 1024;
#pragma unroll
  for (int p = 0; p < 4; ++p) glds16(Ab + aoff[p], dA + p * 4096);
#pragma unroll
  for (int p = 0; p < 2; ++p) glds16(Bb + boff[p], dB + p * 4096);
  const int fsw = (h ^ ((r >> 2) & 3)) * 16;
  const int fa0 = (wm * 128 + r) * 64 + fsw, fa1 = fa0 ^ 32;
  const int fb0 = GA_BYTES + (wn * 64 + r) * 64 + fsw, fb1 = fb0 ^ 32;
  asm volatile("s_waitcnt vmcnt(0)" ::: "memory");
  __syncthreads();
  const int nk = K >> 5;
  const bool skip = (var & 2) != 0;
  for (int kt = 0; kt < nk; ++kt) {
    const int buf = kt & 1;
    if (kt + 1 < nk && !skip) {
      Ab += 64; Bb += 64;
      char* nA = dA + (buf ^ 1) * GSTAGE;
      char* nB = dB + (buf ^ 1) * GSTAGE;
#pragma unroll
      for (int p = 0; p < 4; ++p) glds16(Ab + aoff[p], nA + p * 4096);
#pragma unroll
      for (int p = 0; p < 2; ++p) glds16(Bb + boff[p], nB + p * 4096);
    }
    const char* sb = smem + buf * GSTAGE;
    bf16x8 a0[4], b0[2], a1[4], b1[2];
#pragma unroll
    for (int i = 0; i < 4; ++i) a0[i] = *(const bf16x8*)(sb + fa0 + i * 2048);
#pragma unroll
    for (int j = 0; j < 2; ++j) b0[j] = *(const bf16x8*)(sb + fb0 + j * 2048);
    __builtin_amdgcn_sched_barrier(0);
#pragma unroll
    for (int i = 0; i < 4; ++i) a1[i] = *(const bf16x8*)(sb + fa1 + i * 2048);
#pragma unroll
    for (int j = 0; j < 2; ++j) b1[j] = *(const bf16x8*)(sb + fb1 + j * 2048);
#pragma unroll
    for (int i = 0; i < 4; ++i)
#pragma unroll
      for (int j = 0; j < 2; ++j) {
        if (!TR) acc[i][j] = MFMA32(a0[i], b0[j], acc[i][j]);
        else acc[i][j] = MFMA32(b0[j], a0[i], acc[i][j]);
      }
#pragma unroll
    for (int i = 0; i < 4; ++i)
#pragma unroll
      for (int j = 0; j < 2; ++j) {
        if (!TR) acc[i][j] = MFMA32(a1[i], b1[j], acc[i][j]);
        else acc[i][j] = MFMA32(b1[j], a1[i], acc[i][j]);
      }
#pragma unroll
    for (int g = 0; g < 6; ++g) {
      __builtin_amdgcn_sched_group_barrier(0x008, 1, 0);
      __builtin_amdgcn_sched_group_barrier(0x100, 1, 0);
    }
    __builtin_amdgcn_sched_group_barrier(0x008, 10, 0);
    __builtin_amdgcn_sched_barrier(0);
    asm volatile("s_waitcnt vmcnt(0)" ::: "memory");
    __syncthreads();
  }
}

DI void zero_acc(f32x16 (&acc)[4][2]) {
#pragma unroll
  for (int i = 0; i < 4; ++i)
#pragma unroll
    for (int j = 0; j < 2; ++j)
#pragma unroll
      for (int e = 0; e < 16; ++e) acc[i][j][e] = 0.f;
}

DI void tile_coords(int tidx, int n_super_m, int& mt, int& nt) {
  const int j = tidx >> 9, bb = tidx & 511, xcd = bb & 7, local = bb >> 3;
  const int st = j * 8 + xcd;
  const int sm = st % n_super_m, sn = st / n_super_m;
  mt = sm * 8 + (local & 7);
  nt = sn * 8 + (local >> 3);
}

DI void inproj_tile(const Params& p, int layer, int mt, int nt, char* smem, const int var = 0) {
  unsigned char* ws = p.ws;
  const bf16_t* hb = (const bf16_t*)(ws + OFF_H) + (size_t)mt * 256 * 1024;
  const bf16_t* wb = (const bf16_t*)(ws + OFF_WINT) + (size_t)nt * 128 * 1024;
  const int t = tid_opaque(), lane = t & 63, w = t >> 6, wm = w >> 1, wn = w & 1, r = lane & 31, h = lane >> 5;
  const int split = nt >> 2, kind = split & 3, grp = split >> 2;
  f32x16 acc[4][2];
  zero_acc(acc);
  if (kind == 2) {
    gemm_mainloop<false>(t, hb, 1024, wb, 1024, 1024, smem, acc, var);
    if ((var & 1) && acc[0][0][0] != 12345.678f) return;
    bf16_t* tens = (bf16_t*)(ws + OFF_QKV) + (size_t)(grp * 3 + 2) * TENS;
    const int b = (mt * 256) >> 12, sbase = (mt * 256) & 4095;
#pragma unroll
    for (int j = 0; j < 2; ++j) {
      bf16_t* hp;
      int dv, DV;
      if (grp == 0) { hp = tens + (size_t)(b * 4 + (nt & 3)) * 4096 * 128; dv = wn * 64 + j * 32 + r; DV = 128; }
      else { hp = tens + (size_t)(b * 8 + (nt & 3) * 2 + wn) * 4096 * 64; dv = j * 32 + r; DV = 64; }
#pragma unroll
      for (int i = 0; i < 4; ++i)
#pragma unroll
        for (int g = 0; g < 4; g += 2) {
          const int s0 = sbase + wm * 128 + i * 32 + 8 * (g + h);
          u32x2 pe = {pk2(acc[i][j][4 * g], acc[i][j][4 * g + 1]), pk2(acc[i][j][4 * g + 2], acc[i][j][4 * g + 3])};
          u32x2 po = {pk2(acc[i][j][4 * g + 4], acc[i][j][4 * g + 5]), pk2(acc[i][j][4 * g + 6], acc[i][j][4 * g + 7])};
          *(u32x4*)(hp + ((size_t)((s0 >> 6) * DV + dv)) * 64 + (s0 & 63)) = swap_pair(pe, po);
        }
    }
  } else {
    gemm_mainloop<true>(t, hb, 1024, wb, 1024, 1024, smem, acc, var);
    if ((var & 1) && acc[0][0][0] != 12345.678f) return;
#pragma unroll
    for (int i = 0; i < 4; ++i) {
      const int tok = mt * 256 + wm * 128 + i * 32 + r;
      const int b = tok >> 12, s = tok & 4095;
      if (kind == 3) {
        bf16_t* gp = (bf16_t*)(ws + OFF_G) + (size_t)tok * 1536 + grp * 512 + (nt & 3) * 128 + wn * 64 + 8 * h;
#pragma unroll
        for (int j = 0; j < 2; ++j)
#pragma unroll
          for (int g = 0; g < 4; g += 2) {
            float v[8];
#pragma unroll
            for (int e = 0; e < 8; ++e) { const float a = acc[i][j][4 * g + e]; v[e] = a * __builtin_amdgcn_rcpf(1.f + __expf(-a)); }
            u32x2 pe = {pk2(v[0], v[1]), pk2(v[2], v[3])};
            u32x2 po = {pk2(v[4], v[5]), pk2(v[6], v[7])};
            *(u32x4*)(gp + j * 32 + 8 * g) = swap_pair(pe, po);
          }
      } else {
        const int hh = (nt & 3) * 2 + wn;
        if (grp == 2 && kind == 1) {
          float ss = 0.f;
#pragma unroll
          for (int j = 0; j < 2; ++j)
#pragma unroll
            for (int e = 0; e < 16; ++e) ss += acc[i][j][e] * acc[i][j][e];
          ss = xsum(ss);
#pragma unroll
          for (int o2 = 16; o2; o2 >>= 1) ss = fmaxf(ss, __shfl_xor(ss, o2));
          if (lane == 0) atomicMax((unsigned*)(ws + OFF_KMAX) + layer * 32 + b * 8 + hh, __float_as_uint(ss));
        }
        bf16_t* qp = (bf16_t*)(ws + OFF_QKV) + (size_t)(grp * 3 + kind) * TENS + ((size_t)(b * 8 + hh) * 4096 + s) * 64 + 8 * h;
        const float sc = (kind == 0) ? (grp == 1 ? -0.125f * LOG2E : 0.125f * LOG2E) : 1.f;
        f32x16 a0 = acc[i][0];
        if (grp == 0) {
          const f32x4 cs = *(const f32x4*)((const float*)(ws + OFF_ROPE) + s * 8 + 4 * h);
          const f32x4 sn = *(const f32x4*)((const float*)(ws + OFF_ROPE) + 4096 * 8 + s * 8 + 4 * h);
#pragma unroll
          for (int e = 0; e < 4; ++e) {
            const float r1 = a0[e], r2 = a0[4 + e];
            a0[e] = r1 * cs[e] - r2 * sn[e];
            a0[4 + e] = r2 * cs[e] + r1 * sn[e];
          }
        }
#pragma unroll
        for (int j = 0; j < 2; ++j)
#pragma unroll
          for (int g = 0; g < 4; g += 2) {
            float v[8];
#pragma unroll
            for (int e = 0; e < 8; ++e) v[e] = (j == 0 ? a0[4 * g + e] : acc[i][1][4 * g + e]) * sc;
            u32x2 pe = {pk2(v[0], v[1]), pk2(v[2], v[3])};
            u32x2 po = {pk2(v[4], v[5]), pk2(v[6], v[7])};
            *(u32x4*)(qp + j * 32 + 8 * g) = swap_pair(pe, po);
          }
      }
    }
  }
}

DI void outproj_tile(const Params& p, int layer, int mt, int nt, char* smem) {
  unsigned char* ws = p.ws;
  const bf16_t* ab = (const bf16_t*)(ws + OFF_G) + (size_t)mt * 256 * 1536;
  const bf16_t* wb = (const bf16_t*)(ws + OFF_WOUTT) + (size_t)layer * 1024 * 1536 + (size_t)nt * 128 * 1536;
  const int t = tid_opaque(), lane = t & 63, w = t >> 6, wm = w >> 1, wn = w & 1, r = lane & 31, h = lane >> 5;
  f32x16 acc[4][2];
  zero_acc(acc);
  gemm_mainloop<true>(t, ab, 1536, wb, 1536, 1536, smem, acc);
  bf16_t* y = (bf16_t*)(ws + OFF_QKV);
#pragma unroll
  for (int i = 0; i < 4; ++i) {
    const int tok = mt * 256 + wm * 128 + i * 32 + r;
    bf16_t* yp = y + (size_t)tok * 1024 + nt * 128 + wn * 64 + 8 * h;
#pragma unroll
    for (int j = 0; j < 2; ++j)
#pragma unroll
      for (int g = 0; g < 4; g += 2) {
        u32x2 pe = {pk2(acc[i][j][4 * g], acc[i][j][4 * g + 1]), pk2(acc[i][j][4 * g + 2], acc[i][j][4 * g + 3])};
        u32x2 po = {pk2(acc[i][j][4 * g + 4], acc[i][j][4 * g + 5]), pk2(acc[i][j][4 * g + 6], acc[i][j][4 * g + 7])};
        *(u32x4*)(yp + j * 32 + 8 * g) = swap_pair(pe, po);
      }
  }
}

DI int pi_row(int r) { return (r & 0x13) | ((r & 4) << 1) | ((r & 8) >> 1); }

template <int NR>
DI void tile_gload(const int t, const bf16_t* __restrict__ g, size_t gstride, u32x4* regs) {
  const int lrow = t >> 3, lch = t & 7;
#pragma unroll
  for (int p = 0; p < NR / 32; ++p) regs[p] = *(const u32x4*)(g + (size_t)(lrow + 32 * p) * gstride + lch * 8);
}
template <int NR>
DI void tile_swrite(const int t, bf16_t* s, const u32x4* regs) {
  const int lrow = t >> 3, lch = t & 7;
#pragma unroll
  for (int p = 0; p < NR / 32; ++p) *(u32x4*)(s + (lrow + 32 * p) * LROW + lch * 8) = regs[p];
}

DI float fmax2(float a, float b) { return __builtin_elementwise_maximum(a, b); }
template <int DVB, bool BIAS, bool MASK>
DI void softmax_tile(const bf16_t* sK, const bf16_t* sV, const float* cb, const bf16x8 (&qf)[4], f32x16 (&o)[DVB], float& m, float& l,
                     int prow, int r, int h, int kbase, int qpos) {
  bf16x8 kf[2][4];
#pragma unroll
  for (int sub = 0; sub < 2; ++sub)
#pragma unroll
    for (int ks = 0; ks < 4; ++ks) kf[sub][ks] = *(const bf16x8*)((const char*)sK + (sub * 32 + prow) * 128 + (((2 * ks + h) ^ ((prow >> 1) & 7)) << 4));
  __builtin_amdgcn_sched_barrier(0);
  f32x16 sc[2];
#pragma unroll
  for (int sub = 0; sub < 2; ++sub) {
    f32x16 z;
#pragma unroll
    for (int e = 0; e < 16; ++e) z[e] = 0.f;
    sc[sub] = MFMA32(kf[sub][0], qf[0], z);
#pragma unroll
    for (int ks = 1; ks < 4; ++ks) sc[sub] = MFMA32(kf[sub][ks], qf[ks], sc[sub]);
  }
  bf16x8 vf[2][4];
#pragma unroll
  for (int mb = 0; mb < 2; ++mb)
#pragma unroll
    for (int f = 0; f < 4; ++f) vf[mb][f] = *(const bf16x8*)((const char*)sV + (mb * 32 + r) * 128 + (((2 * f + h) ^ ((r >> 1) & 7)) << 4));
  if (BIAS) {
#pragma unroll
    for (int sub = 0; sub < 2; ++sub)
#pragma unroll
      for (int s2 = 0; s2 < 2; ++s2) {
        const f32x4 c0 = *(const f32x4*)(cb + sub * 32 + s2 * 16 + 8 * h);
        const f32x4 c1 = *(const f32x4*)(cb + sub * 32 + s2 * 16 + 8 * h + 4);
#pragma unroll
        for (int e = 0; e < 4; ++e) {
          sc[sub][8 * s2 + e] -= c0[e];
          sc[sub][8 * s2 + 4 + e] -= c1[e];
        }
      }
  }
  if (MASK) {
#pragma unroll
    for (int sub = 0; sub < 2; ++sub)
#pragma unroll
      for (int e = 0; e < 16; ++e) {
        const int key = kbase + sub * 32 + (e >> 3) * 16 + 8 * h + (e & 7);
        if (key > qpos) sc[sub][e] = -INFINITY;
      }
  }
  float mx = fmax2(sc[0][0], sc[1][0]);
#pragma unroll
  for (int e = 1; e < 16; ++e) mx = fmax2(fmax2(mx, sc[0][e]), sc[1][e]);
  mx = xmax(mx);
  if (__any(mx > m + 16.f)) {
    const float mn = fmaxf(m, mx);
    const float alpha = __builtin_amdgcn_exp2f(m - mn);
    m = mn;
    l *= alpha;
#pragma unroll
    for (int mb = 0; mb < DVB; ++mb)
#pragma unroll
      for (int e = 0; e < 16; ++e) o[mb][e] *= alpha;
  }
  float ls = 0.f;
  bf16x8 pf[4];
#pragma unroll
  for (int sub = 0; sub < 2; ++sub) {
#pragma unroll
    for (int e = 0; e < 16; ++e) { sc[sub][e] = __builtin_amdgcn_exp2f(sc[sub][e] - m); ls += sc[sub][e]; }
    pf[sub * 2 + 0] = pack8(sc[sub][0], sc[sub][1], sc[sub][2], sc[sub][3], sc[sub][4], sc[sub][5], sc[sub][6], sc[sub][7]);
    pf[sub * 2 + 1] = pack8(sc[sub][8], sc[sub][9], sc[sub][10], sc[sub][11], sc[sub][12], sc[sub][13], sc[sub][14], sc[sub][15]);
  }
  l += ls;
#pragma unroll
  for (int mb = 0; mb < 2; ++mb)
#pragma unroll
    for (int f = 0; f < 4; ++f) o[mb] = MFMA32(vf[mb][f], pf[f], o[mb]);
  if (DVB > 2) {
#pragma unroll
    for (int mb = 0; mb < 2; ++mb)
#pragma unroll
      for (int f = 0; f < 4; ++f) vf[mb][f] = *(const bf16x8*)((const char*)sV + ((mb + 2) * 32 + r) * 128 + (((2 * f + h) ^ ((r >> 1) & 7)) << 4));
    __builtin_amdgcn_sched_barrier(0);
#pragma unroll
    for (int mb = 0; mb < 2; ++mb)
#pragma unroll
      for (int f = 0; f < 4; ++f) o[(DVB > 2) ? mb + 2 : mb] = MFMA32(vf[mb][f], pf[f], o[(DVB > 2) ? mb + 2 : mb]);
  }
}

template <bool DIFF>
DI void attn_softmax_item(const Params& p, int layer, int b, int head, int qb, char* smem, bf16_t* gbase, const int var = 0) {
  constexpr int NK = DIFF ? 2 : 1;
  constexpr int DVB = DIFF ? 4 : 2;
  constexpr int VROWS = DVB * 32;
  constexpr int KT_E = 64 * 64, VT_E = VROWS * 64, BUF_E = NK * KT_E + VT_E;
  unsigned char* ws = p.ws;
  bf16_t* sbase = (bf16_t*)smem;
  float* scum = (float*)(smem + 2 * BUF_E * 2);
  const int t = tid_opaque(), lane = t & 63, w = t >> 6, r = lane & 31, h = lane >> 5;
  const int wu = __builtin_amdgcn_readfirstlane(w);
  unsigned soff[4];
#pragma unroll
  for (int pp = 0; pp < 4; ++pp) soff[pp] = (unsigned)((8 * (pp * 4 + wu) + (lane >> 3)) * 128 + (((lane & 7) ^ (((wu & 1) << 2) + ((lane >> 4) & 3))) << 4));
#define ATT_ISSUE(KT, BUF)                                                                                                   \
  {                                                                                                                          \
    char* d_ = smem + (BUF) * (BUF_E * 2) + wu * 1024;                                                                       \
    _Pragma("unroll") for (int c = 0; c < NK; ++c)                                                                           \
      _Pragma("unroll") for (int pp = 0; pp < 2; ++pp)                                                                       \
        glds16((const char*)(Kg[c] + (size_t)(KT) * 64 * 64) + soff[pp], d_ + c * (KT_E * 2) + pp * 4096);                   \
    _Pragma("unroll") for (int pp = 0; pp < VROWS / 32; ++pp)                                                                \
      glds16((const char*)(Vg + (size_t)(KT) * VROWS * 64) + soff[pp], d_ + NK * (KT_E * 2) + pp * 4096);                    \
  }
  const int cw = DIFF ? (w >> 1) : 0;
  const bf16_t* qkv = (const bf16_t*)(ws + OFF_QKV);
  const bf16_t *Qg, *Kg[NK], *Vg;
  if (DIFF) {
#pragma unroll
    for (int c = 0; c < NK; ++c) Kg[c] = qkv + 1 * TENS + (size_t)(b * 8 + head * 2 + c) * 4096 * 64;
    Qg = qkv + 0 * TENS + (size_t)(b * 8 + head * 2 + cw) * 4096 * 64;
    Vg = qkv + 2 * TENS + (size_t)(b * 4 + head) * 128 * 4096;
  } else {
    Qg = qkv + 6 * TENS + (size_t)(b * 8 + head) * 4096 * 64;
    Kg[0] = qkv + 7 * TENS + (size_t)(b * 8 + head) * 4096 * 64;
    Vg = qkv + 8 * TENS + (size_t)(b * 8 + head) * 64 * 4096;
  }
  const float* cumg = (const float*)(ws + OFF_CUM) + (size_t)(b * 8 + head) * 4096;
  const int q0 = DIFF ? (qb * 64 + (w & 1) * 32) : (qb * 128 + w * 32);
  const int qpos = q0 + r;
  bf16x8 qf[4];
#pragma unroll
  for (int ks = 0; ks < 4; ++ks) qf[ks] = *(const bf16x8*)(Qg + (size_t)qpos * 64 + ks * 16 + h * 8);
  f32x16 o[DVB];
  float m = -INFINITY, l = 0.f;
#pragma unroll
  for (int mb = 0; mb < DVB; ++mb)
#pragma unroll
    for (int e = 0; e < 16; ++e) o[mb][e] = 0.f;
  const int ntiles = DIFF ? (qb + 1) : (2 * qb + 2);
  const int last_tile = DIFF ? qb : (2 * qb + (w >> 1));
  const int prow = pi_row(r);
  float qkb = 0.f;
  int* sflag = (int*)(smem + 2 * BUF_E * 2 + 512);
  if (!DIFF) {
    float q2 = 0.f;
#pragma unroll
    for (int ks = 0; ks < 4; ++ks)
#pragma unroll
      for (int e = 0; e < 8; ++e) { const float v = __uint_as_float(((unsigned)(unsigned short)qf[ks][e]) << 16); q2 += v * v; }
    q2 = xsum(q2);
    const float kmax2 = ((const float*)(ws + OFF_KMAX))[layer * 32 + b * 8 + head];
    qkb = sqrtf(q2 * kmax2) * 1.02f + 1.f;
  }
  const int kt0 = DIFF ? 0 : ntiles - 1;
  int wdone = 0;

  float rc = 0.f;
  ATT_ISSUE(kt0, 0)
  if (!DIFF && t < 64) rc = cumg[kt0 * 64 + t];
  asm volatile("s_waitcnt vmcnt(0)" ::: "memory");
  if (!DIFF && t < 64) scum[t] = rc;
  __syncthreads();

  for (int it = 0; it < ntiles; ++it) {
    const int kt = DIFF ? it : ntiles - 1 - it;
    const int kn = DIFF ? it + 1 : kt - 1;
    const bool has_next = (it + 1 < ntiles) && !(var & 1);
    const int buf = it & 1;
    if (has_next) {
      ATT_ISSUE(kn, buf ^ 1)
      if (!DIFF && t < 64) rc = cumg[kn * 64 + t];
    }
    const float* cb = scum + buf * 64;
    if (kt <= last_tile && !wdone && !(var & 2)) {
      const bf16_t* sV = sbase + buf * BUF_E + NK * KT_E;
      const bf16_t* sK = sbase + buf * BUF_E + cw * KT_E;
      if (!DIFF && kt >= 2 * qb) softmax_tile<DVB, !DIFF, true>(sK, sV, cb, qf, o, m, l, prow, r, h, kt * 64, qpos);
      else softmax_tile<DVB, !DIFF, false>(sK, sV, cb, qf, o, m, l, prow, r, h, kt * 64, qpos);
    }
    asm volatile("s_waitcnt vmcnt(0)" ::: "memory");
    if (has_next) {
      if (!DIFF && t < 64) scum[(buf ^ 1) * 64 + t] = rc;
    }
    if (!DIFF) {
      wdone = __all(qkb - cb[0] < m - 138.f);
      if (lane == 0) sflag[buf * 4 + w] = wdone;
    }
    __syncthreads();
    if (!DIFF) {
      if (sflag[buf * 4] & sflag[buf * 4 + 1] & sflag[buf * 4 + 2] & sflag[buf * 4 + 3]) break;
    }
  }
#undef ATT_ISSUE
  if (!DIFF) __syncthreads();

  const int tok = b * 4096 + qpos;
  bf16_t* gp = gbase + (size_t)tok * 1536;
  const float inv = 1.f / xsum(l);
  if (DIFF) {
    float* ex = (float*)smem;
    if (cw == 1) {
#pragma unroll
      for (int mb = 0; mb < DVB; ++mb)
#pragma unroll
        for (int e = 0; e < 16; ++e) ex[(((w & 1) * DVB + mb) * 16 + e) * 64 + lane] = o[mb][e] * inv;
    }
    __syncthreads();
    if (cw == 0) {
      const float* lv = p.dlam + layer * 256;
      float p1 = lv[lane] * lv[64 + lane], p2 = lv[128 + lane] * lv[192 + lane];
      p1 = wave_sum(p1); p2 = wave_sum(p2);
      const float lam_init = 0.2f + (float)layer * (0.6f - 0.6f * 0.74081822068171788f);
      const float lam = expf(p1) - expf(p2) + lam_init;
      float ss = 0.f;
#pragma unroll
      for (int mb = 0; mb < DVB; ++mb)
#pragma unroll
        for (int e = 0; e < 16; ++e) {
          const float v = o[mb][e] * inv - lam * ex[(((w & 1) * DVB + mb) * 16 + e) * 64 + lane];
          o[mb][e] = v;
          ss += v * v;
        }
      ss = xsum(ss);
      const float rn = rsqrtf(ss * (1.f / 128.f) + NORM_EPS) * (1.f - lam_init);
      const float* sg = p.subln + layer * 128;
#pragma unroll
      for (int mb = 0; mb < DVB; ++mb)
#pragma unroll
        for (int g = 0; g < 4; ++g) {
          const int dv = mb * 32 + 8 * g + 4 * h;
          bf16_t* a = gp + head * 128 + dv;
          const u32x2 gt = *(const u32x2*)a;
          const f32x4 gn = *(const f32x4*)(sg + dv);
          const float v0 = o[mb][4 * g] * rn * gn[0] * bflo(gt[0]);
          const float v1 = o[mb][4 * g + 1] * rn * gn[1] * bfhi(gt[0]);
          const float v2 = o[mb][4 * g + 2] * rn * gn[2] * bflo(gt[1]);
          const float v3 = o[mb][4 * g + 3] * rn * gn[3] * bfhi(gt[1]);
          u32x2 st = {pk2(v0, v1), pk2(v2, v3)};
          *(u32x2*)a = st;
        }
    }
    __syncthreads();
  } else {
#pragma unroll
    for (int mb = 0; mb < DVB; ++mb)
#pragma unroll
      for (int g = 0; g < 4; ++g) {
        const int dv = mb * 32 + 8 * g + 4 * h;
        bf16_t* a = gp + 1024 + head * 64 + dv;
        const u32x2 gt = *(const u32x2*)a;
        const float v0 = o[mb][4 * g] * inv * bflo(gt[0]);
        const float v1 = o[mb][4 * g + 1] * inv * bfhi(gt[0]);
        const float v2 = o[mb][4 * g + 2] * inv * bflo(gt[1]);
        const float v3 = o[mb][4 * g + 3] * inv * bfhi(gt[1]);
        u32x2 st = {pk2(v0, v1), pk2(v2, v3)};
        *(u32x2*)a = st;
      }
  }
}

template <bool DIAG>
DI void sb_weights(const f32x16& sc, float& carry, bf16x8& pf0, bf16x8& pf1, int sub, int h, int kbase, int qpos) {
  float beta[16], nb[16];
#pragma unroll
  for (int e = 0; e < 16; ++e) {
    const float u = __builtin_amdgcn_exp2f(sc[e]);
    const float rr = __builtin_amdgcn_rcpf(1.f + u);
    beta[e] = rr;
    nb[e] = 1.f - rr;
  }
  if (DIAG) {
#pragma unroll
    for (int e = 0; e < 16; ++e) {
      const int key = kbase + sub * 32 + (e >> 3) * 16 + 8 * h + (e & 7);
      if (key >= qpos) { beta[e] = 0.f; nb[e] = 1.f; }
    }
  }
  float E[16], Tt[2];
#pragma unroll
  for (int s2 = 0; s2 < 2; ++s2) {
    E[8 * s2 + 7] = 1.f;
#pragma unroll
    for (int j = 6; j >= 0; --j) E[8 * s2 + j] = E[8 * s2 + j + 1] * nb[8 * s2 + j + 1];
    Tt[s2] = E[8 * s2] * nb[8 * s2];
  }
  float T1l, T1h, T0l, T0h;
  xboth(Tt[1], T1l, T1h);
  xboth(Tt[0], T0l, T0h);
  const float c1 = carry * T1h;
  const float c2 = c1 * T1l;
  const float c3 = c2 * T0h;
  const float off1 = h ? carry : c1;
  const float off0 = h ? c2 : c3;
  carry = c3 * T0l;
  float a[16];
#pragma unroll
  for (int e = 0; e < 8; ++e) { a[e] = beta[e] * (E[e] * off0); a[8 + e] = beta[8 + e] * (E[8 + e] * off1); }
  pf0 = pack8(a[0], a[1], a[2], a[3], a[4], a[5], a[6], a[7]);
  pf1 = pack8(a[8], a[9], a[10], a[11], a[12], a[13], a[14], a[15]);
}

template <bool DIAG>
DI void sb_tile(const bf16_t* sK, const bf16_t* sV, const bf16x8 (&qf)[4], f32x16 (&o)[2], float& carry, int prow, int r, int h, int kbase, int qpos) {
  bf16x8 kf[2][4];
#pragma unroll
  for (int sub = 0; sub < 2; ++sub)
#pragma unroll
    for (int ks = 0; ks < 4; ++ks) kf[sub][ks] = *(const bf16x8*)((const char*)sK + (sub * 32 + prow) * 128 + (((2 * ks + h) ^ ((prow >> 1) & 7)) << 4));
  __builtin_amdgcn_sched_barrier(0);
  f32x16 sc[2];
#pragma unroll
  for (int sub = 0; sub < 2; ++sub) {
    f32x16 z;
#pragma unroll
    for (int e = 0; e < 16; ++e) z[e] = 0.f;
    sc[sub] = MFMA32(kf[sub][0], qf[0], z);
#pragma unroll
    for (int ks = 1; ks < 4; ++ks) sc[sub] = MFMA32(kf[sub][ks], qf[ks], sc[sub]);
  }
  bf16x8 vf[2][4];
#pragma unroll
  for (int mb = 0; mb < 2; ++mb)
#pragma unroll
    for (int f = 0; f < 4; ++f) vf[mb][f] = *(const bf16x8*)((const char*)sV + (mb * 32 + r) * 128 + (((2 * f + h) ^ ((r >> 1) & 7)) << 4));
  __builtin_amdgcn_sched_barrier(0);
  bf16x8 pf[4];
  sb_weights<DIAG>(sc[1], carry, pf[2], pf[3], 1, h, kbase, qpos);
  sb_weights<DIAG>(sc[0], carry, pf[0], pf[1], 0, h, kbase, qpos);
#pragma unroll
  for (int mb = 0; mb < 2; ++mb)
#pragma unroll
    for (int f = 0; f < 4; ++f) o[mb] = MFMA32(vf[mb][f], pf[f], o[mb]);
}

DI void attn_sb_item(const Params& p, int b, int head, int qb, char* smem, bf16_t* gbase) {
  constexpr int KT_E = 64 * 64, BUF_E = 2 * KT_E;
  unsigned char* ws = p.ws;
  bf16_t* sbase = (bf16_t*)smem;
  int* sflag = (int*)(smem + 40960);
  const int t = tid_opaque(), lane = t & 63, w = t >> 6, r = lane & 31, h = lane >> 5;
  const int wu = __builtin_amdgcn_readfirstlane(w);
  unsigned soff[2];
#pragma unroll
  for (int pp = 0; pp < 2; ++pp) soff[pp] = (unsigned)((8 * (pp * 4 + wu) + (lane >> 3)) * 128 + (((lane & 7) ^ (((wu & 1) << 2) + ((lane >> 4) & 3))) << 4));
#define SB_ISSUE(KT, BUF)                                                                                     \
  {                                                                                                           \
    char* d_ = smem + (BUF) * (BUF_E * 2) + wu * 1024;                                                        \
    _Pragma("unroll") for (int pp = 0; pp < 2; ++pp) {                                                        \
      glds16((const char*)(Kg + (size_t)(KT) * 64 * 64) + soff[pp], d_ + pp * 4096);                          \
      glds16((const char*)(Vg + (size_t)(KT) * 64 * 64) + soff[pp], d_ + KT_E * 2 + pp * 4096);               \
    }                                                                                                         \
  }
  const bf16_t* qkv = (const bf16_t*)(ws + OFF_QKV);
  const bf16_t* Qg = qkv + 3 * TENS + (size_t)(b * 8 + head) * 4096 * 64;
  const bf16_t* Kg = qkv + 4 * TENS + (size_t)(b * 8 + head) * 4096 * 64;
  const bf16_t* Vg = qkv + 5 * TENS + (size_t)(b * 8 + head) * 64 * 4096;
  const int q0 = qb * 128 + w * 32;
  const int qpos = q0 + r;
  bf16x8 qf[4];
#pragma unroll
  for (int ks = 0; ks < 4; ++ks) qf[ks] = *(const bf16x8*)(Qg + (size_t)qpos * 64 + ks * 16 + h * 8);
  f32x16 o[2];
#pragma unroll
  for (int mb = 0; mb < 2; ++mb)
#pragma unroll
    for (int e = 0; e < 16; ++e) o[mb][e] = 0.f;
  float carry = 1.f;
  const int ntiles = 2 * qb + 2;
  const int first_tile = 2 * qb + (w >> 1);
  const int prow = pi_row(r);

  SB_ISSUE(ntiles - 1, 0)
  asm volatile("s_waitcnt vmcnt(0)" ::: "memory");
  __syncthreads();

  for (int it = 0; it < ntiles; ++it) {
    const int kt = ntiles - 1 - it;
    const int buf = it & 1;
    if (kt > 0) SB_ISSUE(kt - 1, buf ^ 1)
    if (kt <= first_tile && !__all(carry < 0x1p-136f)) {
      const bf16_t* sK = sbase + buf * BUF_E;
      const bf16_t* sV = sK + KT_E;
      if (kt == first_tile) sb_tile<true>(sK, sV, qf, o, carry, prow, r, h, kt * 64, qpos);
      else sb_tile<false>(sK, sV, qf, o, carry, prow, r, h, kt * 64, qpos);
    }
    asm volatile("s_waitcnt vmcnt(0)" ::: "memory");
    const int wdone = __all(carry < 0x1p-136f);
    if (lane == 0) sflag[buf * 4 + w] = wdone;
    __syncthreads();
    if (sflag[buf * 4] & sflag[buf * 4 + 1] & sflag[buf * 4 + 2] & sflag[buf * 4 + 3]) break;
  }
#undef SB_ISSUE
  __syncthreads();
  const int tok = b * 4096 + qpos;
  bf16_t* gp = gbase + (size_t)tok * 1536 + 512 + head * 64;
#pragma unroll
  for (int mb = 0; mb < 2; ++mb)
#pragma unroll
    for (int g = 0; g < 4; ++g) {
      const int dv = mb * 32 + 8 * g + 4 * h;
      bf16_t* a = gp + dv;
      const u32x2 gt = *(const u32x2*)a;
      const float v0 = o[mb][4 * g] * bflo(gt[0]);
      const float v1 = o[mb][4 * g + 1] * bfhi(gt[0]);
      const float v2 = o[mb][4 * g + 2] * bflo(gt[1]);
      const float v3 = o[mb][4 * g + 3] * bfhi(gt[1]);
      u32x2 st = {pk2(v0, v1), pk2(v2, v3)};
      *(u32x2*)a = st;
    }
}

DI bool decode_item(int xq, int q, int& type, int& bh, int& qb) {
  if (q < 128) { type = 0; bh = 2 * xq + (q >> 6); qb = 63 - (q & 63); return true; }
  if (q < 256) { const int j = q - 128; type = 2; bh = 4 * xq + (j & 3); qb = 31 - (j >> 2); return true; }
  if (q < 384) { const int j = q - 256; type = 1; bh = 4 * xq + (j & 3); qb = 31 - (j >> 2); return true; }
  return false;
}

#define XB_TMO      128
#define XB_XCNT(j)  (256  + 64 * (j))
#define XB_XSUB(j)  (1280 + 64 * (j))
#define XB_XGEN(j)  (2304 + 64 * (j))
#define XB_TOP      3328
#define XB_TOPGEN   3392
#define XCD_BAR_WORDS 3456
#define XB_SPIN_CAP (1u << 22)
#define LAS __attribute__((address_space(3)))
DI unsigned xb_ld(unsigned* p) { return __hip_atomic_load(p, __ATOMIC_RELAXED, __HIP_MEMORY_SCOPE_AGENT); }
DI unsigned xb_add(unsigned* p, unsigned v) { return __hip_atomic_fetch_add(p, v, __ATOMIC_RELAXED, __HIP_MEMORY_SCOPE_AGENT); }
DI unsigned xb_xcc_id() { return (unsigned)__builtin_amdgcn_s_getreg((3 << 11) | 20) & 0xFu; }
#define XB_SPIN(cond, bar) do { unsigned _sp = 0; while (cond) { __builtin_amdgcn_s_sleep(1); \
    if ((++_sp & 255u) == 0u) { if (xb_ld(&(bar)[XB_TMO])) break; if (_sp > XB_SPIN_CAP) { atomicAdd(&(bar)[XB_TMO], 1u); break; } } } } while (0)
struct XcdBarrier { unsigned* bar; unsigned x; volatile LAS unsigned* st; };
DI XcdBarrier xcd_barrier_post(unsigned* bar, volatile LAS unsigned* st) {
  XcdBarrier b; b.bar = bar; b.x = xb_xcc_id(); b.st = st;
  if (tid_opaque() == 0) (void)xb_add(&bar[XB_XCNT(b.x)], 1u);
  return b;
}
DI void xcd_barrier_complete(unsigned* bar, unsigned x, unsigned& nloc, unsigned& nx) {
  const unsigned G = gridDim.x * gridDim.y * gridDim.z;
  unsigned sum, cnt, mine, sp = 0u;
  for (;;) {
    sum = 0u; cnt = 0u; mine = 0u;
#pragma unroll
    for (unsigned j = 0; j < 16; ++j) { const unsigned c = xb_ld(&bar[XB_XCNT(j)]); sum += c; cnt += (c > 0u) ? 1u : 0u; mine = (j == x) ? c : mine; }
    if (sum == G) break;
    __builtin_amdgcn_s_sleep(1);
    if ((++sp & 255u) == 0u) { if (xb_ld(&bar[XB_TMO])) break; if (sp > XB_SPIN_CAP) { atomicAdd(&bar[XB_TMO], 1u); break; } }
  }
  nloc = mine > 0u ? mine : 1u; nx = cnt > 0u ? cnt : 1u;
}
DI void xcd_barrier_impl(const XcdBarrier& b) {
  asm volatile("s_waitcnt vmcnt(0)" ::: "memory");
  __syncthreads();
  if (tid_opaque() == 0) {
    unsigned* bar = b.bar;
    __builtin_amdgcn_s_waitcnt(0);
    unsigned nloc = b.st[0], nx = b.st[1];
    if (nloc == 0u) { xcd_barrier_complete(bar, b.x, nloc, nx); b.st[0] = nloc; b.st[1] = nx; }
    const unsigned old = xb_add(&bar[XB_XSUB(b.x)], 1u);
    const unsigned gen = old / nloc;
    if (old + 1u == (gen + 1u) * nloc) {
      __builtin_amdgcn_fence(__ATOMIC_RELEASE, "agent");
      asm volatile("s_waitcnt vmcnt(0)" ::: "memory");
      const unsigned og = xb_add(&bar[XB_TOP], 1u);
      const unsigned tg = og / nx;
      if (og + 1u == (tg + 1u) * nx) xb_add(&bar[XB_TOPGEN], 1u);
      else XB_SPIN(xb_ld(&bar[XB_TOPGEN]) == tg, bar);
      __builtin_amdgcn_fence(__ATOMIC_ACQUIRE, "agent");
      xb_add(&bar[XB_XGEN(b.x)], 1u);
      asm volatile("s_waitcnt vmcnt(0)" ::: "memory");
    } else {
      XB_SPIN(xb_ld(&bar[XB_XGEN(b.x)]) == gen, bar);
      __builtin_amdgcn_fence(__ATOMIC_ACQUIRE, "agent");
      asm volatile("s_waitcnt vmcnt(0)" ::: "memory");
    }
  }
  __syncthreads();
}
DI void xcd_barrier(const Params& p, volatile LAS unsigned* st) {
  XcdBarrier b; b.bar = (unsigned*)(p.ws + OFF_BAR); b.x = xb_xcc_id(); b.st = st;
  xcd_barrier_impl(b);
}

DI void phase_setup(const Params& p, char* smem) {
  unsigned char* ws = p.ws;
  const int nb = gridDim.x, bid = bid_opaque(), t = tid_opaque();
  if (bid == 0 && t < 64) { ((unsigned*)(ws + OFF_CTR))[t] = 0u; ((float*)(ws + OFF_KMAX))[t] = 0.f; }
  for (int e = bid * 256 + t; e < 4096 * 8; e += nb * 256) {
    const int s = e >> 3, i = e & 7;
    const float inv = powf(500000.0f, -(float)(2 * i) / 16.0f);
    const float ang = (float)s * inv;
    float sn, cs;
    sincosf(ang, &sn, &cs);
    ((float*)(ws + OFF_ROPE))[e] = cs;
    ((float*)(ws + OFF_ROPE))[4096 * 8 + e] = sn;
  }
  for (int it = bid; it < 1536; it += nb) {
    const int nblk = it % 96, kblk = it / 96;
    transpose_tile(p.w_in, DIN, (bf16_t*)(ws + OFF_WINT), 1024, kblk * 64, nblk * 64, smem);
  }
  stage_wf(p.w_in, smem);
  const int lane = t & 63, w = t >> 6;
#pragma unroll 1
  for (int row = bid * 4 + w; row < T; row += nb * 4) {
    f32x4 xv[4];
#pragma unroll
    for (int pp = 0; pp < 4; ++pp) xv[pp] = __builtin_nontemporal_load((const f32x4*)(p.x + (size_t)row * 1024 + 256 * pp + 4 * lane));
    prenorm_row(xv, p.gpre, (const float*)smem, p.fbias, (bf16_t*)(ws + OFF_H), (float*)(ws + OFF_LF), row, lane);
  }
  __syncthreads();
}

DI void phase_inproj(const Params& p, int layer, char* smem, int* s_item, const int var = 0) {
  unsigned char* ws = p.ws;
  for (int seq = blockIdx.x; seq < 32; seq += gridDim.x) cumsum_item((const float*)(ws + OFF_LF), (float*)(ws + OFF_CUM), seq, smem);
  if (var != 0) {
    for (int ti = blockIdx.x; ti < 64 * 48; ti += gridDim.x) {
      int mt, nt;
      tile_coords(ti, 8, mt, nt);
      inproj_tile(p, layer, mt, nt, smem, var);
    }
    return;
  }
  unsigned* ctr = (unsigned*)(ws + OFF_CTR) + 16 + layer * 8;
  const int home = (int)(xb_xcc_id() & 7u);
  const int t = tid_opaque();
  int cur = home, pend = 0;
  if (t == 0) pend = (int)atomicAdd(ctr + cur, 1u);
  for (;;) {
    if (t == 0) {
      int code = -1;
      for (;;) {
        if (pend < 384) { code = (cur << 16) | pend; break; }
        int best = 99, nxt = -1;
#pragma unroll
        for (int x = 0; x < 8; ++x) {
          const unsigned cx = xb_ld(ctr + x);
          const int d = (x - home) & 7;
          if (cx < 384u && d < best) { best = d; nxt = x; }
        }
        if (nxt < 0) break;
        cur = nxt;
        pend = (int)atomicAdd(ctr + cur, 1u);
      }
      *s_item = code;
    }
    __syncthreads();
    const int code = *s_item;
    __syncthreads();
    if (code < 0) break;
    if (t == 0) pend = (int)atomicAdd(ctr + cur, 1u);
    const int xq = code >> 16, q = code & 0xffff;
    const int ti = (q >> 6) * 512 + (q & 63) * 8 + xq;
    int mt, nt;
    tile_coords(ti, 8, mt, nt);
    inproj_tile(p, layer, mt, nt, smem, 0);
  }
}

DI void phase_attn(const Params& p, int layer, char* smem, int* s_item, const int ctr_base = 0, const int type_mask = 7, bf16_t* gbase = nullptr, const int var = 0) {
  unsigned* ctr = (unsigned*)(p.ws + OFF_CTR) + ctr_base + layer * 8;
  if (gbase == nullptr) gbase = (bf16_t*)(p.ws + OFF_G);
  const int home = (int)(xb_xcc_id() & 7u);
  const int t = tid_opaque();
  int step = 0, pend = 0;
  if (t == 0) pend = (int)atomicAdd(ctr + (home & 7), 1u);
  for (;;) {
    if (t == 0) {
      int code = -1;
      while (step < 8) {
        if (pend < 384) { code = (((home + step) & 7) << 16) | pend; break; }
        ++step;
        if (step < 8) pend = (int)atomicAdd(ctr + ((home + step) & 7), 1u);
      }
      *s_item = code;
    }
    __syncthreads();
    const int code = *s_item;
    __syncthreads();
    if (code < 0) break;
    if (t == 0) pend = (int)atomicAdd(ctr + ((home + step) & 7), 1u);
    int type, bh, qb;
    if (!decode_item(code >> 16, code & 0xffff, type, bh, qb)) break;
    if (!((type_mask >> type) & 1)) continue;
    if (type == 0) attn_softmax_item<true>(p, layer, bh >> 2, bh & 3, qb, smem, gbase, var);
    else if (type == 1) attn_sb_item(p, bh >> 3, bh & 7, qb, smem, gbase);
    else attn_softmax_item<false>(p, layer, bh >> 3, bh & 7, qb, smem, gbase, var);
  }
  if (layer == 0 && ctr_base == 0) {
    unsigned* tctr = (unsigned*)(p.ws + OFF_CTR) + 60;
    for (;;) {
      if (t == 0) *s_item = (int)atomicAdd(tctr, 1u);
      __syncthreads();
      const int it = *s_item;
      __syncthreads();
      if (it >= 768 + 1536) break;
      if (it < 768) {
        const int lay = it / 384, jj = it % 384;
        const int nblk = jj % 16, kblk = jj / 16;
        transpose_tile(p.w_out + (size_t)lay * 1536 * 1024, 1024, (bf16_t*)(p.ws + OFF_WOUTT) + (size_t)lay * 1024 * 1536, 1536, kblk * 64, nblk * 64, smem);
      } else {
        const int j = it - 768;
        const int nblk = j % 96, kblk = j / 96;
        transpose_tile(p.w_in + (size_t)1024 * DIN, DIN, (bf16_t*)(p.ws + OFF_WINT), 1024, kblk * 64, nblk * 64, smem);
      }
    }
  }
}

DI void phase_outproj(const Params& p, int layer, char* smem) {
  for (int ti = blockIdx.x; ti < 64 * 8; ti += gridDim.x) {
    int mt, nt;
    tile_coords(ti, 8, mt, nt);
    outproj_tile(p, layer, mt, nt, smem);
  }
}

DI void phase_postnorm(const Params& p, int layer, char* smem) {
  unsigned char* ws = p.ws;
  const int t = tid_opaque(), lane = t & 63, w = t >> 6;
  if (layer == 0) stage_wf(p.w_in + (size_t)1024 * DIN, smem);
  const bf16_t* y = (const bf16_t*)(ws + OFF_QKV);
  const float* xin = (layer == 0) ? p.x : p.out;
  const float* gpost = p.gpost + layer * 1024;
#pragma unroll 1
  for (int row = blockIdx.x * 4 + w; row < T; row += gridDim.x * 4) {
    f32x4 yv[4], xv[4];
    float ss = 0.f;
#pragma unroll
    for (int pp = 0; pp < 4; ++pp) {
      const u32x2 yb = __builtin_nontemporal_load((const u32x2*)(y + (size_t)row * 1024 + 256 * pp + 4 * lane));
      yv[pp][0] = bflo(yb[0]); yv[pp][1] = bfhi(yb[0]); yv[pp][2] = bflo(yb[1]); yv[pp][3] = bfhi(yb[1]);
      xv[pp] = __builtin_nontemporal_load((const f32x4*)(xin + (size_t)row * 1024 + 256 * pp + 4 * lane));
#pragma unroll
      for (int i = 0; i < 4; ++i) ss += yv[pp][i] * yv[pp][i];
    }
    ss = wave_sum(ss);
    const float rinv = rsqrtf(ss * (1.f / 1024.f) + NORM_EPS);
#pragma unroll
    for (int pp = 0; pp < 4; ++pp) {
      const f32x4 g = *(const f32x4*)(gpost + 256 * pp + 4 * lane);
#pragma unroll
      for (int i = 0; i < 4; ++i) xv[pp][i] += yv[pp][i] * rinv * g[i];
      *(f32x4*)(p.out + (size_t)row * 1024 + 256 * pp + 4 * lane) = xv[pp];
    }
    if (layer == 0)
      prenorm_row(xv, p.gpre + 1024, (const float*)smem, p.fbias + 8, (bf16_t*)(ws + OFF_H), (float*)(ws + OFF_LF), row, lane);
  }
  __syncthreads();
}

__global__ void __launch_bounds__(256, 2) fwd_kernel(Params p) {
  __shared__ __attribute__((aligned(1024))) char smem[SMEM_BYTES];
  __shared__ uint4 xb_words;
  __shared__ int s_item;
  if (tid_opaque() == 0) xb_words = make_uint4(0u, 0u, 0u, 0u);
  __syncthreads();
  (void)xcd_barrier_post((unsigned*)(p.ws + OFF_BAR), (volatile LAS unsigned*)&xb_words);
  if (p.ws == nullptr) cg::this_grid().sync();
  for (int rep = 0; rep < (DUP_PHASE == 0 ? 2 : 1); ++rep) { phase_setup(p, smem); xcd_barrier(p, (volatile LAS unsigned*)&xb_words); }
#pragma unroll 1
  for (int layer = 0; layer < 2; ++layer) {
    for (int rep = 0; rep < (DUP_PHASE == 1 ? 2 - layer : 1); ++rep) { phase_inproj(p, layer, smem, &s_item, rep ? EXP_VAR : 0); xcd_barrier(p, (volatile LAS unsigned*)&xb_words); }
    phase_attn(p, layer, smem, &s_item);
    xcd_barrier(p, (volatile LAS unsigned*)&xb_words);
    if (DUP_PHASE == 2 && layer == 0) { phase_attn(p, layer, smem, &s_item, 32, EXP_VAR & 7, (bf16_t*)p.out, EXP_VAR >> 3); xcd_barrier(p, (volatile LAS unsigned*)&xb_words); }
    for (int rep = 0; rep < (DUP_PHASE == 3 ? 2 - layer : 1); ++rep) { phase_outproj(p, layer, smem); xcd_barrier(p, (volatile LAS unsigned*)&xb_words); }
    for (int rep = 0; rep < (DUP_PHASE == 4 ? 2 - layer : 1); ++rep) { phase_postnorm(p, layer, smem); if (layer == 0) xcd_barrier(p, (volatile LAS unsigned*)&xb_words); }
  }
}

extern "C" void kernel_launch(void* const* d_in, const int* in_sizes, int n_in, void* d_out, int out_size, void* d_ws, size_t ws_size,
                              hipStream_t stream) {
  static int grid_blocks = 0;
  if (!grid_blocks) {
    int dev = 0, cus = 0, per_cu = 0;
    (void)hipGetDevice(&dev);
    (void)hipDeviceGetAttribute(&cus, hipDeviceAttributeMultiprocessorCount, dev);
    (void)hipOccupancyMaxActiveBlocksPerMultiprocessor(&per_cu, fwd_kernel, 256, 0);
    if (per_cu > 2) per_cu = 2;
    if (per_cu < 1) per_cu = 1;
    grid_blocks = cus * per_cu;
    if (ws_size < WS_NEED) fprintf(stderr, "workspace too small: %zu < %zu\n", ws_size, WS_NEED);
  }
  Params p{};
  p.x = (const float*)d_in[0]; p.w_in = (const float*)d_in[1]; p.fbias = (const float*)d_in[2]; p.dlam = (const float*)d_in[3];
  p.subln = (const float*)d_in[4]; p.w_out = (const float*)d_in[5]; p.gpre = (const float*)d_in[6]; p.gpost = (const float*)d_in[7];
  p.out = (float*)d_out; p.ws = (unsigned char*)d_ws;
  (void)hipMemsetAsync((unsigned char*)d_ws + OFF_BAR, 0, XCD_BAR_WORDS * 4, stream);
  void* args[] = {&p};
  hipError_t e = hipLaunchCooperativeKernel((void*)fwd_kernel, dim3(grid_blocks), dim3(256), args, 0, stream);
  if (e != hipSuccess) fprintf(stderr, "cooperative launch failed: %s (grid %d)\n", hipGetErrorString(e), grid_blocks);
}
```

```cpp
#include <hip/hip_runtime.h>
#include <hip/hip_cooperative_groups.h>
#include <cstdio>
namespace cg = cooperative_groups;

#ifndef EXP_VAR
#define EXP_VAR 0
#endif
#ifndef DUP_PHASE
#define DUP_PHASE -1
#endif

typedef unsigned short bf16_t;
typedef short bf16x8 __attribute__((ext_vector_type(8)));
typedef float f32x16 __attribute__((ext_vector_type(16)));
typedef float f32x4 __attribute__((ext_vector_type(4)));
typedef float f32x2 __attribute__((ext_vector_type(2)));
typedef __bf16 bf16x2n __attribute__((ext_vector_type(2)));
typedef unsigned u32x2 __attribute__((ext_vector_type(2)));
typedef unsigned u32x4 __attribute__((ext_vector_type(4)));

#define DI __device__ __forceinline__
#define MFMA32(a, b, c) __builtin_amdgcn_mfma_f32_32x32x16_bf16((a), (b), (c), 0, 0, 0)

constexpr int T = 16384, S = 4096, D = 1024, DIN = 6152, DMIX = 1536;
constexpr int LROW = 72;
constexpr float LOG2E = 1.4426950408889634f;
constexpr float NORM_EPS = 1e-6f;
constexpr int SMEM_BYTES = 73728;

constexpr size_t OFF_WINT = 0;
constexpr size_t OFF_WOUTT = OFF_WINT + (size_t)6144 * 1024 * 2;
constexpr size_t OFF_H = OFF_WOUTT + (size_t)2 * 1024 * 1536 * 2;
constexpr size_t OFF_QKV = OFF_H + (size_t)T * 1024 * 2;
constexpr size_t TENS = (size_t)T * 512;
constexpr size_t OFF_G = OFF_QKV + 9 * TENS * 2;
constexpr size_t OFF_LF = OFF_G + (size_t)T * 1536 * 2;
constexpr size_t OFF_CUM = OFF_LF + (size_t)32 * 4096 * 4;
constexpr size_t OFF_ROPE = OFF_CUM + (size_t)32 * 4096 * 4;
constexpr size_t OFF_CTR = OFF_ROPE + (size_t)2 * 4096 * 8 * 4;
constexpr size_t OFF_KMAX = OFF_CTR + 1024;
constexpr size_t OFF_BAR = OFF_CTR + 4096;
constexpr size_t WS_NEED = OFF_BAR + 16384;

struct Params {
  const float* x; const float* w_in; const float* fbias; const float* dlam; const float* subln;
  const float* w_out; const float* gpre; const float* gpost; float* out; unsigned char* ws;
};

DI int tid_opaque() { int t = threadIdx.x; asm volatile("" : "+v"(t)); return t; }
DI int bid_opaque() { int b = blockIdx.x; asm volatile("" : "+s"(b)); return b; }
DI unsigned pk2(float a, float b) { f32x2 v = {a, b}; bf16x2n r = __builtin_convertvector(v, bf16x2n); return __builtin_bit_cast(unsigned, r); }
DI float bflo(unsigned u) { return __uint_as_float(u << 16); }
DI float bfhi(unsigned u) { return __uint_as_float(u & 0xffff0000u); }
DI float wave_sum(float v) {
#pragma unroll
  for (int o = 32; o; o >>= 1) v += __shfl_xor(v, o);
  return v;
}
DI float xhalf(float v) { return __shfl_xor(v, 32); }
DI float xmax(float v) {
  auto r = __builtin_amdgcn_permlane32_swap(__float_as_uint(v), __float_as_uint(v), false, false);
  return fmaxf(__uint_as_float(r[0]), __uint_as_float(r[1]));
}
DI float xsum(float v) {
  auto r = __builtin_amdgcn_permlane32_swap(__float_as_uint(v), __float_as_uint(v), false, false);
  return __uint_as_float(r[0]) + __uint_as_float(r[1]);
}
DI void xboth(float v, float& lo, float& hi) {
  auto r = __builtin_amdgcn_permlane32_swap(__float_as_uint(v), __float_as_uint(v), false, false);
  lo = __uint_as_float(r[0]); hi = __uint_as_float(r[1]);
}
DI u32x4 swap_pair(u32x2 pe, u32x2 po) {
  auto r0 = __builtin_amdgcn_permlane32_swap(pe[0], po[0], false, false);
  auto r1 = __builtin_amdgcn_permlane32_swap(pe[1], po[1], false, false);
  u32x4 o = {r0[0], r1[0], r0[1], r1[1]};
  return o;
}
DI bf16x8 pack8(float a0, float a1, float a2, float a3, float a4, float a5, float a6, float a7) {
  u32x4 u = {pk2(a0, a1), pk2(a2, a3), pk2(a4, a5), pk2(a6, a7)};
  return __builtin_bit_cast(bf16x8, u);
}
DI float log_sigmoid_f(float v) { return fminf(v, 0.f) - __logf(1.f + __expf(-fabsf(v))); }

DI void transpose_tile(const float* __restrict__ src, int ldn, bf16_t* __restrict__ dst, int K, int k0, int n0, char* smem) {
  float* tile = (float*)smem;
  const int t = tid_opaque();
#pragma unroll
  for (int p = 0; p < 16; ++p) {
    const int k = p * 4 + (t >> 6), n = t & 63;
    tile[k * 65 + n] = src[(size_t)(k0 + k) * ldn + n0 + n];
  }
  __syncthreads();
#pragma unroll
  for (int p = 0; p < 8; ++p) {
    const int n = p * 8 + (t >> 5), k = (t & 31) * 2;
    *(unsigned*)(dst + (size_t)(n0 + n) * K + k0 + k) = pk2(tile[k * 65 + n], tile[(k + 1) * 65 + n]);
  }
  __syncthreads();
}

DI void stage_wf(const float* __restrict__ w_in_l, char* smem) {
  float* wf = (float*)smem;
  const int t0 = tid_opaque();
  for (int e = t0; e < 2048; e += 256) {
    const int k = e >> 1, half = e & 1;
    const f32x4 v = *(const f32x4*)(w_in_l + (size_t)k * DIN + 6144 + half * 4);
#pragma unroll
    for (int i = 0; i < 4; ++i) wf[(half * 4 + i) * 1024 + k] = v[i];
  }
  __syncthreads();
}

DI void prenorm_row(const f32x4 (&xv)[4], const float* __restrict__ gpre, const float* wf, const float* __restrict__ fbias,
                    bf16_t* __restrict__ hbuf, float* __restrict__ lf, int tok, int lane) {
  float ss = 0.f;
#pragma unroll
  for (int p = 0; p < 4; ++p)
#pragma unroll
    for (int i = 0; i < 4; ++i) ss += xv[p][i] * xv[p][i];
  ss = wave_sum(ss);
  const float rinv = rsqrtf(ss * (1.f / 1024.f) + NORM_EPS);
  float ff[8];
#pragma unroll
  for (int hh = 0; hh < 8; ++hh) ff[hh] = 0.f;
#pragma unroll
  for (int p = 0; p < 4; ++p) {
    const f32x4 g = *(const f32x4*)(gpre + 256 * p + 4 * lane);
    f32x4 hv;
#pragma unroll
    for (int i = 0; i < 4; ++i) hv[i] = xv[p][i] * rinv * g[i];
    u32x2 st = {pk2(hv[0], hv[1]), pk2(hv[2], hv[3])};
    *(u32x2*)(hbuf + (size_t)tok * 1024 + 256 * p + 4 * lane) = st;
#pragma unroll
    for (int hh = 0; hh < 8; ++hh) {
      const f32x4 w = *(const f32x4*)(wf + hh * 1024 + 256 * p + 4 * lane);
      ff[hh] += hv[0] * w[0] + hv[1] * w[1] + hv[2] * w[2] + hv[3] * w[3];
    }
    __builtin_amdgcn_sched_barrier(0);
  }
  float mine = 0.f;
#pragma unroll
  for (int hh = 0; hh < 8; ++hh) {
    const float s = wave_sum(ff[hh]);
    if (lane == hh) mine = s;
  }
  if (lane < 8) lf[((size_t)(tok >> 12) * 8 + lane) * 4096 + (tok & 4095)] = log_sigmoid_f(mine + fbias[lane]);
}

DI void cumsum_item(const float* __restrict__ lf, float* __restrict__ cum, int seq, char* smem) {
  float* sm = (float*)smem;
  const int t = tid_opaque(), lane = t & 63, w = t >> 6;
  float v[16];
#pragma unroll
  for (int p = 0; p < 4; ++p) {
    const f32x4 a = *(const f32x4*)(lf + (size_t)seq * 4096 + 16 * t + 4 * p);
#pragma unroll
    for (int i = 0; i < 4; ++i) v[4 * p + i] = a[i];
  }
#pragma unroll
  for (int i = 1; i < 16; ++i) v[i] += v[i - 1];
  float tot = v[15];
  float inc = tot;
#pragma unroll
  for (int o = 1; o < 64; o <<= 1) { const float n = __shfl_up(inc, o); if (lane >= o) inc += n; }
  if (lane == 63) sm[w] = inc;
  __syncthreads();
  float base = inc - tot;
  for (int i = 0; i < w; ++i) base += sm[i];
#pragma unroll
  for (int p = 0; p < 4; ++p) {
    f32x4 a;
#pragma unroll
    for (int i = 0; i < 4; ++i) a[i] = (v[4 * p + i] + base) * LOG2E;
    *(f32x4*)(cum + (size_t)seq * 4096 + 16 * t + 4 * p) = a;
  }
  __syncthreads();
}

constexpr int GA_BYTES = 256 * 64, GB_BYTES = 128 * 64, GSTAGE = GA_BYTES + GB_BYTES;
typedef __attribute__((address_space(3))) void* lds_vp;
typedef const __attribute__((address_space(1))) void* glb_vp;
DI void glds16(const char* g, char* lds_wave_base) {
  __builtin_amdgcn_global_load_lds((glb_vp)(unsigned long long)g, (lds_vp)(unsigned)(unsigned long long)lds_wave_base, 16, 0, 0);
}
template <bool TR>
DI void gemm_mainloop(const int t, const bf16_t* __restrict__ A, int lda, const bf16_t* __restrict__ B, int ldb, int K, char* smem, f32x16 (&acc)[4][2], const int var = 0) {
  const int lane = t & 63, w = t >> 6, wm = w >> 1, wn = w & 1, r = lane & 31, h = lane >> 5;
  const int wu = __builtin_amdgcn_readfirstlane(w);
  const int srow = lane >> 2, schunk = (lane & 3) ^ ((lane >> 4) & 3);
  unsigned aoff[4], boff[2];
#pragma unroll
  for (int p = 0; p < 4; ++p) aoff[p] = (unsigned)((((p * 4 + wu) * 16 + srow) * lda + schunk * 8) * 2);
#pragma unroll
  for (int p = 0; p < 2; ++p) boff[p] = (unsigned)((((p * 4 + wu) * 16 + srow) * ldb + schunk * 8) * 2);
  const char* Ab = (const char*)A;
  const char* Bb = (const char*)B;
  char* dA = smem + wu * 1024;
  char* dB = smem + GA_BYTES + wu * 1024;
#pragma unroll
  for (int p = 0; p < 4; ++p) glds16(Ab + aoff[p], dA + p * 4096);
#pragma unroll
  for (int p = 0; p < 2; ++p) glds16(Bb + boff[p], dB + p * 4096);
  const int fsw = (h ^ ((r >> 2) & 3)) * 16;
  const int fa0 = (wm * 128 + r) * 64 + fsw, fa1 = fa0 ^ 32;
  const int fb0 = GA_BYTES + (wn * 64 + r) * 64 + fsw, fb1 = fb0 ^ 32;
  asm volatile("s_waitcnt vmcnt(0)" ::: "memory");
  __syncthreads();
  const int nk = K >> 5;
  const bool skip = (var & 2) != 0;
  for (int kt = 0; kt < nk; ++kt) {
    const int buf = kt & 1;
    if (kt + 1 < nk && !skip) {
      Ab += 64; Bb += 64;
      char* nA = dA + (buf ^ 1) * GSTAGE;
      char* nB = dB + (buf ^ 1) * GSTAGE;
#pragma unroll
      for (int p = 0; p < 4; ++p) glds16(Ab + aoff[p], nA + p * 4096);
#pragma unroll
      for (int p = 0; p < 2; ++p) glds16(Bb + boff[p], nB + p * 4096);
    }
    const char* sb = smem + buf * GSTAGE;
    bf16x8 a0[4], b0[2], a1[4], b1[2];
#pragma unroll
    for (int i = 0; i < 4; ++i) a0[i] = *(const bf16x8*)(sb + fa0 + i * 2048);
#pragma unroll
    for (int j = 0; j < 2; ++j) b0[j] = *(const bf16x8*)(sb + fb0 + j * 2048);
    __builtin_amdgcn_sched_barrier(0);
#pragma unroll
    for (int i = 0; i < 4; ++i) a1[i] = *(const bf16x8*)(sb + fa1 + i * 2048);
#pragma unroll
    for (int j = 0; j < 2; ++j) b1[j] = *(const bf16x8*)(sb + fb1 + j * 2048);
#pragma unroll
    for (int i = 0; i < 4; ++i)
#pragma unroll
      for (int j = 0; j < 2; ++j) {
        if (!TR) acc[i][j] = MFMA32(a0[i], b0[j], acc[i][j]);
        else acc[i][j] = MFMA32(b0[j], a0[i], acc[i][j]);
      }
#pragma unroll
    for (int i = 0; i < 4; ++i)
#pragma unroll
      for (int j = 0; j < 2; ++j) {
        if (!TR) acc[i][j] = MFMA32(a1[i], b1[j], acc[i][j]);
        else acc[i][j] = MFMA32(b1[j], a1[i], acc[i][j]);
      }
#pragma unroll
    for (int g = 0; g < 6; ++g) {
      __builtin_amdgcn_sched_group_barrier(0x008, 1, 0);
      __builtin_amdgcn_sched_group_barrier(0x100, 1, 0);
    }
    __builtin_amdgcn_sched_group_barrier(0x008, 10, 0);
    __builtin_amdgcn_sched_barrier(0);
    asm volatile("s_waitcnt vmcnt(0)" ::: "memory");
    __syncthreads();
  }
}

DI void zero_acc(f32x16 (&acc)[4][2]) {
#pragma unroll
  for (int i = 0; i < 4; ++i)
#pragma unroll
    for (int j = 0; j < 2; ++j)
#pragma unroll
      for (int e = 0; e < 16; ++e) acc[i][j][e] = 0.f;
}

DI void tile_coords(int tidx, int n_super_m, int& mt, int& nt) {
  const int j = tidx >> 9, bb = tidx & 511, xcd = bb & 7, local = bb >> 3;
  const int st = j * 8 + xcd;
  const int sm = st % n_super_m, sn = st / n_super_m;
  mt = sm * 8 + (local & 7);
  nt = sn * 8 + (local >> 3);
}

DI void inproj_tile(const Params& p, int layer, int mt, int nt, char* smem, const int var = 0) {
  unsigned char* ws = p.ws;
  const bf16_t* hb = (const bf16_t*)(ws + OFF_H) + (size_t)mt * 256 * 1024;
  const bf16_t* wb = (const bf16_t*)(ws + OFF_WINT) + (size_t)nt * 128 * 1024;
  const int t = tid_opaque(), lane = t & 63, w = t >> 6, wm = w >> 1, wn = w & 1, r = lane & 31, h = lane >> 5;
  const int split = nt >> 2, kind = split & 3, grp = split >> 2;
  f32x16 acc[4][2];
  zero_acc(acc);
  if (kind == 2) {
    gemm_mainloop<false>(t, hb, 1024, wb, 1024, 1024, smem, acc, var);
    if ((var & 1) && acc[0][0][0] != 12345.678f) return;
    bf16_t* tens = (bf16_t*)(ws + OFF_QKV) + (size_t)(grp * 3 + 2) * TENS;
    const int b = (mt * 256) >> 12, sbase = (mt * 256) & 4095;
#pragma unroll
    for (int j = 0; j < 2; ++j) {
      bf16_t* hp;
      int dv, DV;
      if (grp == 0) { hp = tens + (size_t)(b * 4 + (nt & 3)) * 4096 * 128; dv = wn * 64 + j * 32 + r; DV = 128; }
      else { hp = tens + (size_t)(b * 8 + (nt & 3) * 2 + wn) * 4096 * 64; dv = j * 32 + r; DV = 64; }
#pragma unroll
      for (int i = 0; i < 4; ++i)
#pragma unroll
        for (int g = 0; g < 4; g += 2) {
          const int s0 = sbase + wm * 128 + i * 32 + 8 * (g + h);
          u32x2 pe = {pk2(acc[i][j][4 * g], acc[i][j][4 * g + 1]), pk2(acc[i][j][4 * g + 2], acc[i][j][4 * g + 3])};
          u32x2 po = {pk2(acc[i][j][4 * g + 4], acc[i][j][4 * g + 5]), pk2(acc[i][j][4 * g + 6], acc[i][j][4 * g + 7])};
          *(u32x4*)(hp + ((size_t)((s0 >> 6) * DV + dv)) * 64 + (s0 & 63)) = swap_pair(pe, po);
        }
    }
  } else {
    gemm_mainloop<true>(t, hb, 1024, wb, 1024, 1024, smem, acc, var);
    if ((var & 1) && acc[0][0][0] != 12345.678f) return;
#pragma unroll
    for (int i = 0; i < 4; ++i) {
      const int tok = mt * 256 + wm * 128 + i * 32 + r;
      const int b = tok >> 12, s = tok & 4095;
      if (kind == 3) {
        bf16_t* gp = (bf16_t*)(ws + OFF_G) + (size_t)tok * 1536 + grp * 512 + (nt & 3) * 128 + wn * 64 + 8 * h;
#pragma unroll
        for (int j = 0; j < 2; ++j)
#pragma unroll
          for (int g = 0; g < 4; g += 2) {
            float v[8];
#pragma unroll
            for (int e = 0; e < 8; ++e) { const float a = acc[i][j][4 * g + e]; v[e] = a * __builtin_amdgcn_rcpf(1.f + __expf(-a)); }
            u32x2 pe = {pk2(v[0], v[1]), pk2(v[2], v[3])};
            u32x2 po = {pk2(v[4], v[5]), pk2(v[6], v[7])};
            *(u32x4*)(gp + j * 32 + 8 * g) = swap_pair(pe, po);
          }
      } else {
        const int hh = (nt & 3) * 2 + wn;
        if (grp == 2 && kind == 1) {
          float ss = 0.f;
#pragma unroll
          for (int j = 0; j < 2; ++j)
#pragma unroll
            for (int e = 0; e < 16; ++e) ss += acc[i][j][e] * acc[i][j][e];
          ss = xsum(ss);
#pragma unroll
          for (int o2 = 16; o2; o2 >>= 1) ss = fmaxf(ss, __shfl_xor(ss, o2));
          if (lane == 0) atomicMax((unsigned*)(ws + OFF_KMAX) + layer * 32 + b * 8 + hh, __float_as_uint(ss));
        }
        bf16_t* qp = (bf16_t*)(ws + OFF_QKV) + (size_t)(grp * 3 + kind) * TENS + ((size_t)(b * 8 + hh) * 4096 + s) * 64 + 8 * h;
        const float sc = (kind == 0) ? (grp == 1 ? -0.125f * LOG2E : 0.125f * LOG2E) : 1.f;
        f32x16 a0 = acc[i][0];
        if (grp == 0) {
          const f32x4 cs = *(const f32x4*)((const float*)(ws + OFF_ROPE) + s * 8 + 4 * h);
          const f32x4 sn = *(const f32x4*)((const float*)(ws + OFF_ROPE) + 4096 * 8 + s * 8 + 4 * h);
#pragma unroll
          for (int e = 0; e < 4; ++e) {
            const float r1 = a0[e], r2 = a0[4 + e];
            a0[e] = r1 * cs[e] - r2 * sn[e];
            a0[4 + e] = r2 * cs[e] + r1 * sn[e];
          }
        }
#pragma unroll
        for (int j = 0; j < 2; ++j)
#pragma unroll
          for (int g = 0; g < 4; g += 2) {
            float v[8];
#pragma unroll
            for (int e = 0; e < 8; ++e) v[e] = (j == 0 ? a0[4 * g + e] : acc[i][1][4 * g + e]) * sc;
            u32x2 pe = {pk2(v[0], v[1]), pk2(v[2], v[3])};
            u32x2 po = {pk2(v[4], v[5]), pk2(v[6], v[7])};
            *(u32x4*)(qp + j * 32 + 8 * g) = swap_pair(pe, po);
          }
      }
    }
  }
}

DI void outproj_tile(const Params& p, int layer, int mt, int nt, char* smem) {
  unsigned char* ws = p.ws;
  const bf16_t* ab = (const bf16_t*)(ws + OFF_G) + (size_t)mt * 256 * 1536;
  const bf16_t* wb = (const bf16_t*)(ws + OFF_WOUTT) + (size_t)layer * 1024 * 1536 + (size_t)nt * 128 * 1536;
  const int t = tid_opaque(), lane = t & 63, w = t >> 6, wm = w >> 1, wn = w & 1, r = lane & 31, h = lane >> 5;
  f32x16 acc[4][2];
  zero_acc(acc);
  gemm_mainloop<true>(t, ab, 1536, wb, 1536, 1536, smem, acc);
  bf16_t* y = (bf16_t*)(ws + OFF_QKV);
#pragma unroll
  for (int i = 0; i < 4; ++i) {
    const int tok = mt * 256 + wm * 128 + i * 32 + r;
    bf16_t* yp = y + (size_t)tok * 1024 + nt * 128 + wn * 64 + 8 * h;
#pragma unroll
    for (int j = 0; j < 2; ++j)
#pragma unroll
      for (int g = 0; g < 4; g += 2) {
        u32x2 pe = {pk2(acc[i][j][4 * g], acc[i][j][4 * g + 1]), pk2(acc[i][j][4 * g + 2], acc[i][j][4 * g + 3])};
        u32x2 po = {pk2(acc[i][j][4 * g + 4], acc[i][j][4 * g + 5]), pk2(acc[i][j][4 * g + 6], acc[i][j][4 * g + 7])};
        *(u32x4*)(yp + j * 32 + 8 * g) = swap_pair(pe, po);
      }
  }
}

DI int pi_row(int r) { return (r & 0x13) | ((r & 4) << 1) | ((r & 8) >> 1); }

template <int NR>
DI void tile_gload(const int t, const bf16_t* __restrict__ g, size_t gstride, u32x4* regs) {
  const int lrow = t >> 3, lch = t & 7;
#pragma unroll
  for (int p = 0; p < NR / 32; ++p) regs[p] = *(const u32x4*)(g + (size_t)(lrow + 32 * p) * gstride + lch * 8);
}
template <int NR>
DI void tile_swrite(const int t, bf16_t* s, const u32x4* regs) {
  const int lrow = t >> 3, lch = t & 7;
#pragma unroll
  for (int p = 0; p < NR / 32; ++p) *(u32x4*)(s + (lrow + 32 * p) * LROW + lch * 8) = regs[p];
}

DI float fmax2(float a, float b) { return __builtin_elementwise_maximum(a, b); }
template <int DVB, bool BIAS, bool MASK>
DI void softmax_tile(const bf16_t* sK, const bf16_t* sV, const float* cb, const bf16x8 (&qf)[4], f32x16 (&o)[DVB], float& m, float& l,
                     int prow, int r, int h, int kbase, int qpos) {
  bf16x8 kf[2][4];
#pragma unroll
  for (int sub = 0; sub < 2; ++sub)
#pragma unroll
    for (int ks = 0; ks < 4; ++ks) kf[sub][ks] = *(const bf16x8*)((const char*)sK + (sub * 32 + prow) * 128 + (((2 * ks + h) ^ ((prow >> 1) & 7)) << 4));
  __builtin_amdgcn_sched_barrier(0);
  f32x16 sc[2];
#pragma unroll
  for (int sub = 0; sub < 2; ++sub) {
    f32x16 z;
#pragma unroll
    for (int e = 0; e < 16; ++e) z[e] = 0.f;
    sc[sub] = MFMA32(kf[sub][0], qf[0], z);
#pragma unroll
    for (int ks = 1; ks < 4; ++ks) sc[sub] = MFMA32(kf[sub][ks], qf[ks], sc[sub]);
  }
  bf16x8 vf[2][4];
#pragma unroll
  for (int mb = 0; mb < 2; ++mb)
#pragma unroll
    for (int f = 0; f < 4; ++f) vf[mb][f] = *(const bf16x8*)((const char*)sV + (mb * 32 + r) * 128 + (((2 * f + h) ^ ((r >> 1) & 7)) << 4));
  if (BIAS) {
#pragma unroll
    for (int sub = 0; sub < 2; ++sub)
#pragma unroll
      for (int s2 = 0; s2 < 2; ++s2) {
        const f32x4 c0 = *(const f32x4*)(cb + sub * 32 + s2 * 16 + 8 * h);
        const f32x4 c1 = *(const f32x4*)(cb + sub * 32 + s2 * 16 + 8 * h + 4);
#pragma unroll
        for (int e = 0; e < 4; ++e) {
          sc[sub][8 * s2 + e] -= c0[e];
          sc[sub][8 * s2 + 4 + e] -= c1[e];
        }
      }
  }
  if (MASK) {
#pragma unroll
    for (int sub = 0; sub < 2; ++sub)
#pragma unroll
      for (int e = 0; e < 16; ++e) {
        const int key = kbase + sub * 32 + (e >> 3) * 16 + 8 * h + (e & 7);
        if (key > qpos) sc[sub][e] = -INFINITY;
      }
  }
  float mx = fmax2(sc[0][0], sc[1][0]);
#pragma unroll
  for (int e = 1; e < 16; ++e) mx = fmax2(fmax2(mx, sc[0][e]), sc[1][e]);
  mx = xmax(mx);
  if (__any(mx > m + 8.f)) {
    const float mn = fmaxf(m, mx);
    const float alpha = __builtin_amdgcn_exp2f(m - mn);
    m = mn;
    l *= alpha;
#pragma unroll
    for (int mb = 0; mb < DVB; ++mb)
#pragma unroll
      for (int e = 0; e < 16; ++e) o[mb][e] *= alpha;
  }
  float ls = 0.f;
  bf16x8 pf[4];
#pragma unroll
  for (int sub = 0; sub < 2; ++sub) {
#pragma unroll
    for (int e = 0; e < 16; ++e) { sc[sub][e] = __builtin_amdgcn_exp2f(sc[sub][e] - m); ls += sc[sub][e]; }
    pf[sub * 2 + 0] = pack8(sc[sub][0], sc[sub][1], sc[sub][2], sc[sub][3], sc[sub][4], sc[sub][5], sc[sub][6], sc[sub][7]);
    pf[sub * 2 + 1] = pack8(sc[sub][8], sc[sub][9], sc[sub][10], sc[sub][11], sc[sub][12], sc[sub][13], sc[sub][14], sc[sub][15]);
  }
  l += ls;
#pragma unroll
  for (int mb = 0; mb < 2; ++mb)
#pragma unroll
    for (int f = 0; f < 4; ++f) o[mb] = MFMA32(vf[mb][f], pf[f], o[mb]);
  if (DVB > 2) {
#pragma unroll
    for (int mb = 0; mb < 2; ++mb)
#pragma unroll
      for (int f = 0; f < 4; ++f) vf[mb][f] = *(const bf16x8*)((const char*)sV + ((mb + 2) * 32 + r) * 128 + (((2 * f + h) ^ ((r >> 1) & 7)) << 4));
    __builtin_amdgcn_sched_barrier(0);
#pragma unroll
    for (int mb = 0; mb < 2; ++mb)
#pragma unroll
      for (int f = 0; f < 4; ++f) o[(DVB > 2) ? mb + 2 : mb] = MFMA32(vf[mb][f], pf[f], o[(DVB > 2) ? mb + 2 : mb]);
  }
}

template <bool DIFF>
DI void attn_softmax_item(const Params& p, int layer, int b, int head, int qb, char* smem, bf16_t* gbase, const int var = 0) {
  constexpr int NK = DIFF ? 2 : 1;
  constexpr int DVB = DIFF ? 4 : 2;
  constexpr int VROWS = DVB * 32;
  constexpr int KT_E = 64 * 64, VT_E = VROWS * 64, BUF_E = NK * KT_E + VT_E;
  unsigned char* ws = p.ws;
  bf16_t* sbase = (bf16_t*)smem;
  float* scum = (float*)(smem + 2 * BUF_E * 2);
  const int t = tid_opaque(), lane = t & 63, w = t >> 6, r = lane & 31, h = lane >> 5;
  const int wu = __builtin_amdgcn_readfirstlane(w);
  unsigned soff[4];
#pragma unroll
  for (int pp = 0; pp < 4; ++pp) soff[pp] = (unsigned)((8 * (pp * 4 + wu) + (lane >> 3)) * 128 + (((lane & 7) ^ (((wu & 1) << 2) + ((lane >> 4) & 3))) << 4));
#define ATT_ISSUE(KT, BUF)                                                                                                   \
  {                                                                                                                          \
    char* d_ = smem + (BUF) * (BUF_E * 2) + wu * 1024;                                                                       \
    _Pragma("unroll") for (int c = 0; c < NK; ++c)                                                                           \
      _Pragma("unroll") for (int pp = 0; pp < 2; ++pp)                                                                       \
        glds16((const char*)(Kg[c] + (size_t)(KT) * 64 * 64) + soff[pp], d_ + c * (KT_E * 2) + pp * 4096);                   \
    _Pragma("unroll") for (int pp = 0; pp < VROWS / 32; ++pp)                                                                \
      glds16((const char*)(Vg + (size_t)(KT) * VROWS * 64) + soff[pp], d_ + NK * (KT_E * 2) + pp * 4096);                    \
  }
  const int cw = DIFF ? (w >> 1) : 0;
  const bf16_t* qkv = (const bf16_t*)(ws + OFF_QKV);
  const bf16_t *Qg, *Kg[NK], *Vg;
  if (DIFF) {
#pragma unroll
    for (int c = 0; c < NK; ++c) Kg[c] = qkv + 1 * TENS + (size_t)(b * 8 + head * 2 + c) * 4096 * 64;
    Qg = qkv + 0 * TENS + (size_t)(b * 8 + head * 2 + cw) * 4096 * 64;
    Vg = qkv + 2 * TENS + (size_t)(b * 4 + head) * 128 * 4096;
  } else {
    Qg = qkv + 6 * TENS + (size_t)(b * 8 + head) * 4096 * 64;
    Kg[0] = qkv + 7 * TENS + (size_t)(b * 8 + head) * 4096 * 64;
    Vg = qkv + 8 * TENS + (size_t)(b * 8 + head) * 64 * 4096;
  }
  const float* cumg = (const float*)(ws + OFF_CUM) + (size_t)(b * 8 + head) * 4096;
  const int q0 = DIFF ? (qb * 64 + (w & 1) * 32) : (qb * 128 + w * 32);
  const int qpos = q0 + r;
  bf16x8 qf[4];
#pragma unroll
  for (int ks = 0; ks < 4; ++ks) qf[ks] = *(const bf16x8*)(Qg + (size_t)qpos * 64 + ks * 16 + h * 8);
  f32x16 o[DVB];
  float m = -INFINITY, l = 0.f;
#pragma unroll
  for (int mb = 0; mb < DVB; ++mb)
#pragma unroll
    for (int e = 0; e < 16; ++e) o[mb][e] = 0.f;
  const int ntiles = DIFF ? (qb + 1) : (2 * qb + 2);
  const int last_tile = DIFF ? qb : (2 * qb + (w >> 1));
  const int prow = pi_row(r);
  float qkb = 0.f;
  int* sflag = (int*)(smem + 2 * BUF_E * 2 + 512);
  if (!DIFF) {
    float q2 = 0.f;
#pragma unroll
    for (int ks = 0; ks < 4; ++ks)
#pragma unroll
      for (int e = 0; e < 8; ++e) { const float v = __uint_as_float(((unsigned)(unsigned short)qf[ks][e]) << 16); q2 += v * v; }
    q2 = xsum(q2);
    const float kmax2 = ((const float*)(ws + OFF_KMAX))[layer * 32 + b * 8 + head];
    qkb = sqrtf(q2 * kmax2) * 1.02f + 1.f;
  }
  const int kt0 = DIFF ? 0 : ntiles - 1;
  int wdone = 0;

  float rc = 0.f;
  ATT_ISSUE(kt0, 0)
  if (!DIFF && t < 64) rc = cumg[kt0 * 64 + t];
  asm volatile("s_waitcnt vmcnt(0)" ::: "memory");
  if (!DIFF && t < 64) scum[t] = rc;
  __syncthreads();

  for (int it = 0; it < ntiles; ++it) {
    const int kt = DIFF ? it : ntiles - 1 - it;
    const int kn = DIFF ? it + 1 : kt - 1;
    const bool has_next = (it + 1 < ntiles) && !(var & 1);
    const int buf = it & 1;
    if (has_next) {
      ATT_ISSUE(kn, buf ^ 1)
      if (!DIFF && t < 64) rc = cumg[kn * 64 + t];
    }
    const float* cb = scum + buf * 64;
    if (kt <= last_tile && !wdone && !(var & 2)) {
      const bf16_t* sV = sbase + buf * BUF_E + NK * KT_E;
      const bf16_t* sK = sbase + buf * BUF_E + cw * KT_E;
      if (!DIFF && kt >= 2 * qb) softmax_tile<DVB, !DIFF, true>(sK, sV, cb, qf, o, m, l, prow, r, h, kt * 64, qpos);
      else softmax_tile<DVB, !DIFF, false>(sK, sV, cb, qf, o, m, l, prow, r, h, kt * 64, qpos);
    }
    asm volatile("s_waitcnt vmcnt(0)" ::: "memory");
    if (has_next) {
      if (!DIFF && t < 64) scum[(buf ^ 1) * 64 + t] = rc;
    }
    if (!DIFF) {
      wdone = __all(qkb - cb[0] < m - 138.f);
      if (lane == 0) sflag[buf * 4 + w] = wdone;
    }
    __syncthreads();
    if (!DIFF) {
      if (sflag[buf * 4] & sflag[buf * 4 + 1] & sflag[buf * 4 + 2] & sflag[buf * 4 + 3]) break;
    }
  }
#undef ATT_ISSUE
  if (!DIFF) __syncthreads();

  const int tok = b * 4096 + qpos;
  bf16_t* gp = gbase + (size_t)tok * 1536;
  const float inv = 1.f / xsum(l);
  if (DIFF) {
    float* ex = (float*)smem;
    if (cw == 1) {
#pragma unroll
      for (int mb = 0; mb < DVB; ++mb)
#pragma unroll
        for (int e = 0; e < 16; ++e) ex[(((w & 1) * DVB + mb) * 16 + e) * 64 + lane] = o[mb][e] * inv;
    }
    __syncthreads();
    if (cw == 0) {
      const float* lv = p.dlam + layer * 256;
      float p1 = lv[lane] * lv[64 + lane], p2 = lv[128 + lane] * lv[192 + lane];
      p1 = wave_sum(p1); p2 = wave_sum(p2);
      const float lam_init = 0.2f + (float)layer * (0.6f - 0.6f * 0.74081822068171788f);
      const float lam = expf(p1) - expf(p2) + lam_init;
      float ss = 0.f;
#pragma unroll
      for (int mb = 0; mb < DVB; ++mb)
#pragma unroll
        for (int e = 0; e < 16; ++e) {
          const float v = o[mb][e] * inv - lam * ex[(((w & 1) * DVB + mb) * 16 + e) * 64 + lane];
          o[mb][e] = v;
          ss += v * v;
        }
      ss = xsum(ss);
      const float rn = rsqrtf(ss * (1.f / 128.f) + NORM_EPS) * (1.f - lam_init);
      const float* sg = p.subln + layer * 128;
#pragma unroll
      for (int mb = 0; mb < DVB; ++mb)
#pragma unroll
        for (int g = 0; g < 4; ++g) {
          const int dv = mb * 32 + 8 * g + 4 * h;
          bf16_t* a = gp + head * 128 + dv;
          const u32x2 gt = *(const u32x2*)a;
          const f32x4 gn = *(const f32x4*)(sg + dv);
          const float v0 = o[mb][4 * g] * rn * gn[0] * bflo(gt[0]);
          const float v1 = o[mb][4 * g + 1] * rn * gn[1] * bfhi(gt[0]);
          const float v2 = o[mb][4 * g + 2] * rn * gn[2] * bflo(gt[1]);
          const float v3 = o[mb][4 * g + 3] * rn * gn[3] * bfhi(gt[1]);
          u32x2 st = {pk2(v0, v1), pk2(v2, v3)};
          *(u32x2*)a = st;
        }
    }
    __syncthreads();
  } else {
#pragma unroll
    for (int mb = 0; mb < DVB; ++mb)
#pragma unroll
      for (int g = 0; g < 4; ++g) {
        const int dv = mb * 32 + 8 * g + 4 * h;
        bf16_t* a = gp + 1024 + head * 64 + dv;
        const u32x2 gt = *(const u32x2*)a;
        const float v0 = o[mb][4 * g] * inv * bflo(gt[0]);
        const float v1 = o[mb][4 * g + 1] * inv * bfhi(gt[0]);
        const float v2 = o[mb][4 * g + 2] * inv * bflo(gt[1]);
        const float v3 = o[mb][4 * g + 3] * inv * bfhi(gt[1]);
        u32x2 st = {pk2(v0, v1), pk2(v2, v3)};
        *(u32x2*)a = st;
      }
  }
}

template <bool DIAG>
DI void sb_weights(const f32x16& sc, float& carry, bf16x8& pf0, bf16x8& pf1, int sub, int h, int kbase, int qpos) {
  float beta[16], nb[16];
#pragma unroll
  for (int e = 0; e < 16; ++e) {
    const float u = __builtin_amdgcn_exp2f(sc[e]);
    const float rr = __builtin_amdgcn_rcpf(1.f + u);
    beta[e] = rr;
    nb[e] = 1.f - rr;
  }
  if (DIAG) {
#pragma unroll
    for (int e = 0; e < 16; ++e) {
      const int key = kbase + sub * 32 + (e >> 3) * 16 + 8 * h + (e & 7);
      if (key >= qpos) { beta[e] = 0.f; nb[e] = 1.f; }
    }
  }
  float E[16], Tt[2];
#pragma unroll
  for (int s2 = 0; s2 < 2; ++s2) {
    E[8 * s2 + 7] = 1.f;
#pragma unroll
    for (int j = 6; j >= 0; --j) E[8 * s2 + j] = E[8 * s2 + j + 1] * nb[8 * s2 + j + 1];
    Tt[s2] = E[8 * s2] * nb[8 * s2];
  }
  float T1l, T1h, T0l, T0h;
  xboth(Tt[1], T1l, T1h);
  xboth(Tt[0], T0l, T0h);
  const float c1 = carry * T1h;
  const float c2 = c1 * T1l;
  const float c3 = c2 * T0h;
  const float off1 = h ? carry : c1;
  const float off0 = h ? c2 : c3;
  carry = c3 * T0l;
  float a[16];
#pragma unroll
  for (int e = 0; e < 8; ++e) { a[e] = beta[e] * (E[e] * off0); a[8 + e] = beta[8 + e] * (E[8 + e] * off1); }
  pf0 = pack8(a[0], a[1], a[2], a[3], a[4], a[5], a[6], a[7]);
  pf1 = pack8(a[8], a[9], a[10], a[11], a[12], a[13], a[14], a[15]);
}

template <bool DIAG>
DI void sb_tile(const bf16_t* sK, const bf16_t* sV, const bf16x8 (&qf)[4], f32x16 (&o)[2], float& carry, int prow, int r, int h, int kbase, int qpos) {
  bf16x8 kf[2][4];
#pragma unroll
  for (int sub = 0; sub < 2; ++sub)
#pragma unroll
    for (int ks = 0; ks < 4; ++ks) kf[sub][ks] = *(const bf16x8*)((const char*)sK + (sub * 32 + prow) * 128 + (((2 * ks + h) ^ ((prow >> 1) & 7)) << 4));
  __builtin_amdgcn_sched_barrier(0);
  f32x16 sc[2];
#pragma unroll
  for (int sub = 0; sub < 2; ++sub) {
    f32x16 z;
#pragma unroll
    for (int e = 0; e < 16; ++e) z[e] = 0.f;
    sc[sub] = MFMA32(kf[sub][0], qf[0], z);
#pragma unroll
    for (int ks = 1; ks < 4; ++ks) sc[sub] = MFMA32(kf[sub][ks], qf[ks], sc[sub]);
  }
  bf16x8 vf[2][4];
#pragma unroll
  for (int mb = 0; mb < 2; ++mb)
#pragma unroll
    for (int f = 0; f < 4; ++f) vf[mb][f] = *(const bf16x8*)((const char*)sV + (mb * 32 + r) * 128 + (((2 * f + h) ^ ((r >> 1) & 7)) << 4));
  __builtin_amdgcn_sched_barrier(0);
  bf16x8 pf[4];
  sb_weights<DIAG>(sc[1], carry, pf[2], pf[3], 1, h, kbase, qpos);
  sb_weights<DIAG>(sc[0], carry, pf[0], pf[1], 0, h, kbase, qpos);
#pragma unroll
  for (int mb = 0; mb < 2; ++mb)
#pragma unroll
    for (int f = 0; f < 4; ++f) o[mb] = MFMA32(vf[mb][f], pf[f], o[mb]);
}

DI void attn_sb_item(const Params& p, int b, int head, int qb, char* smem, bf16_t* gbase) {
  constexpr int KT_E = 64 * 64, BUF_E = 2 * KT_E;
  unsigned char* ws = p.ws;
  bf16_t* sbase = (bf16_t*)smem;
  int* sflag = (int*)(smem + 40960);
  const int t = tid_opaque(), lane = t & 63, w = t >> 6, r = lane & 31, h = lane >> 5;
  const int wu = __builtin_amdgcn_readfirstlane(w);
  unsigned soff[2];
#pragma unroll
  for (int pp = 0; pp < 2; ++pp) soff[pp] = (unsigned)((8 * (pp * 4 + wu) + (lane >> 3)) * 128 + (((lane & 7) ^ (((wu & 1) << 2) + ((lane >> 4) & 3))) << 4));
#define SB_ISSUE(KT, BUF)                                                                                     \
  {                                                                                                           \
    char* d_ = smem + (BUF) * (BUF_E * 2) + wu * 1024;                                                        \
    _Pragma("unroll") for (int pp = 0; pp < 2; ++pp) {                                                        \
      glds16((const char*)(Kg + (size_t)(KT) * 64 * 64) + soff[pp], d_ + pp * 4096);                          \
      glds16((const char*)(Vg + (size_t)(KT) * 64 * 64) + soff[pp], d_ + KT_E * 2 + pp * 4096);               \
    }                                                                                                         \
  }
  const bf16_t* qkv = (const bf16_t*)(ws + OFF_QKV);
  const bf16_t* Qg = qkv + 3 * TENS + (size_t)(b * 8 + head) * 4096 * 64;
  const bf16_t* Kg = qkv + 4 * TENS + (size_t)(b * 8 + head) * 4096 * 64;
  const bf16_t* Vg = qkv + 5 * TENS + (size_t)(b * 8 + head) * 64 * 4096;
  const int q0 = qb * 128 + w * 32;
  const int qpos = q0 + r;
  bf16x8 qf[4];
#pragma unroll
  for (int ks = 0; ks < 4; ++ks) qf[ks] = *(const bf16x8*)(Qg + (size_t)qpos * 64 + ks * 16 + h * 8);
  f32x16 o[2];
#pragma unroll
  for (int mb = 0; mb < 2; ++mb)
#pragma unroll
    for (int e = 0; e < 16; ++e) o[mb][e] = 0.f;
  float carry = 1.f;
  const int ntiles = 2 * qb + 2;
  const int first_tile = 2 * qb + (w >> 1);
  const int prow = pi_row(r);

  SB_ISSUE(ntiles - 1, 0)
  asm volatile("s_waitcnt vmcnt(0)" ::: "memory");
  __syncthreads();

  for (int it = 0; it < ntiles; ++it) {
    const int kt = ntiles - 1 - it;
    const int buf = it & 1;
    if (kt > 0) SB_ISSUE(kt - 1, buf ^ 1)
    if (kt <= first_tile && !__all(carry < 0x1p-136f)) {
      const bf16_t* sK = sbase + buf * BUF_E;
      const bf16_t* sV = sK + KT_E;
      if (kt == first_tile) sb_tile<true>(sK, sV, qf, o, carry, prow, r, h, kt * 64, qpos);
      else sb_tile<false>(sK, sV, qf, o, carry, prow, r, h, kt * 64, qpos);
    }
    asm volatile("s_waitcnt vmcnt(0)" ::: "memory");
    const int wdone = __all(carry < 0x1p-136f);
    if (lane == 0) sflag[buf * 4 + w] = wdone;
    __syncthreads();
    if (sflag[buf * 4] & sflag[buf * 4 + 1] & sflag[buf * 4 + 2] & sflag[buf * 4 + 3]) break;
  }
#undef SB_ISSUE
  __syncthreads();
  const int tok = b * 4096 + qpos;
  bf16_t* gp = gbase + (size_t)tok * 1536 + 512 + head * 64;
#pragma unroll
  for (int mb = 0; mb < 2; ++mb)
#pragma unroll
    for (int g = 0; g < 4; ++g) {
      const int dv = mb * 32 + 8 * g + 4 * h;
      bf16_t* a = gp + dv;
      const u32x2 gt = *(const u32x2*)a;
      const float v0 = o[mb][4 * g] * bflo(gt[0]);
      const float v1 = o[mb][4 * g + 1] * bfhi(gt[0]);
      const float v2 = o[mb][4 * g + 2] * bflo(gt[1]);
      const float v3 = o[mb][4 * g + 3] * bfhi(gt[1]);
      u32x2 st = {pk2(v0, v1), pk2(v2, v3)};
      *(u32x2*)a = st;
    }
}

DI bool decode_item(int xq, int q, int& type, int& bh, int& qb) {
  if (q < 128) { type = 0; bh = 2 * xq + (q >> 6); qb = 63 - (q & 63); return true; }
  if (q < 256) { const int j = q - 128; type = 2; bh = 4 * xq + (j & 3); qb = 31 - (j >> 2); return true; }
  if (q < 384) { const int j = q - 256; type = 1; bh = 4 * xq + (j & 3); qb = 31 - (j >> 2); return true; }
  return false;
}

#define XB_TMO      128
#define XB_XCNT(j)  (256  + 64 * (j))
#define XB_XSUB(j)  (1280 + 64 * (j))
#define XB_XGEN(j)  (2304 + 64 * (j))
#define XB_TOP      3328
#define XB_TOPGEN   3392
#define XCD_BAR_WORDS 3456
#define XB_SPIN_CAP (1u << 22)
#define LAS __attribute__((address_space(3)))
DI unsigned xb_ld(unsigned* p) { return __hip_atomic_load(p, __ATOMIC_RELAXED, __HIP_MEMORY_SCOPE_AGENT); }
DI unsigned xb_add(unsigned* p, unsigned v) { return __hip_atomic_fetch_add(p, v, __ATOMIC_RELAXED, __HIP_MEMORY_SCOPE_AGENT); }
DI unsigned xb_xcc_id() { return (unsigned)__builtin_amdgcn_s_getreg((3 << 11) | 20) & 0xFu; }
#define XB_SPIN(cond, bar) do { unsigned _sp = 0; while (cond) { __builtin_amdgcn_s_sleep(1); \
    if ((++_sp & 255u) == 0u) { if (xb_ld(&(bar)[XB_TMO])) break; if (_sp > XB_SPIN_CAP) { atomicAdd(&(bar)[XB_TMO], 1u); break; } } } } while (0)
struct XcdBarrier { unsigned* bar; unsigned x; volatile LAS unsigned* st; };
DI XcdBarrier xcd_barrier_post(unsigned* bar, volatile LAS unsigned* st) {
  XcdBarrier b; b.bar = bar; b.x = xb_xcc_id(); b.st = st;
  if (tid_opaque() == 0) (void)xb_add(&bar[XB_XCNT(b.x)], 1u);
  return b;
}
DI void xcd_barrier_complete(unsigned* bar, unsigned x, unsigned& nloc, unsigned& nx) {
  const unsigned G = gridDim.x * gridDim.y * gridDim.z;
  unsigned sum, cnt, mine, sp = 0u;
  for (;;) {
    sum = 0u; cnt = 0u; mine = 0u;
#pragma unroll
    for (unsigned j = 0; j < 16; ++j) { const unsigned c = xb_ld(&bar[XB_XCNT(j)]); sum += c; cnt += (c > 0u) ? 1u : 0u; mine = (j == x) ? c : mine; }
    if (sum == G) break;
    __builtin_amdgcn_s_sleep(1);
    if ((++sp & 255u) == 0u) { if (xb_ld(&bar[XB_TMO])) break; if (sp > XB_SPIN_CAP) { atomicAdd(&bar[XB_TMO], 1u); break; } }
  }
  nloc = mine > 0u ? mine : 1u; nx = cnt > 0u ? cnt : 1u;
}
DI void xcd_barrier_impl(const XcdBarrier& b) {
  asm volatile("s_waitcnt vmcnt(0)" ::: "memory");
  __syncthreads();
  if (tid_opaque() == 0) {
    unsigned* bar = b.bar;
    __builtin_amdgcn_s_waitcnt(0);
    unsigned nloc = b.st[0], nx = b.st[1];
    if (nloc == 0u) { xcd_barrier_complete(bar, b.x, nloc, nx); b.st[0] = nloc; b.st[1] = nx; }
    const unsigned old = xb_add(&bar[XB_XSUB(b.x)], 1u);
    const unsigned gen = old / nloc;
    if (old + 1u == (gen + 1u) * nloc) {
      __builtin_amdgcn_fence(__ATOMIC_RELEASE, "agent");
      asm volatile("s_waitcnt vmcnt(0)" ::: "memory");
      const unsigned og = xb_add(&bar[XB_TOP], 1u);
      const unsigned tg = og / nx;
      if (og + 1u == (tg + 1u) * nx) xb_add(&bar[XB_TOPGEN], 1u);
      else XB_SPIN(xb_ld(&bar[XB_TOPGEN]) == tg, bar);
      __builtin_amdgcn_fence(__ATOMIC_ACQUIRE, "agent");
      xb_add(&bar[XB_XGEN(b.x)], 1u);
      asm volatile("s_waitcnt vmcnt(0)" ::: "memory");
    } else {
      XB_SPIN(xb_ld(&bar[XB_XGEN(b.x)]) == gen, bar);
      __builtin_amdgcn_fence(__ATOMIC_ACQUIRE, "agent");
      asm volatile("s_waitcnt vmcnt(0)" ::: "memory");
    }
  }
  __syncthreads();
}
DI void xcd_barrier(const Params& p, volatile LAS unsigned* st) {
  XcdBarrier b; b.bar = (unsigned*)(p.ws + OFF_BAR); b.x = xb_xcc_id(); b.st = st;
  xcd_barrier_impl(b);
}

DI void phase_setup(const Params& p, char* smem) {
  unsigned char* ws = p.ws;
  const int nb = gridDim.x, bid = bid_opaque(), t = tid_opaque();
  if (bid == 0 && t < 64) { ((unsigned*)(ws + OFF_CTR))[t] = 0u; ((float*)(ws + OFF_KMAX))[t] = 0.f; }
  for (int e = bid * 256 + t; e < 4096 * 8; e += nb * 256) {
    const int s = e >> 3, i = e & 7;
    const float inv = powf(500000.0f, -(float)(2 * i) / 16.0f);
    const float ang = (float)s * inv;
    float sn, cs;
    sincosf(ang, &sn, &cs);
    ((float*)(ws + OFF_ROPE))[e] = cs;
    ((float*)(ws + OFF_ROPE))[4096 * 8 + e] = sn;
  }
  for (int it = bid; it < 1536; it += nb) {
    const int nblk = it % 96, kblk = it / 96;
    transpose_tile(p.w_in, DIN, (bf16_t*)(ws + OFF_WINT), 1024, kblk * 64, nblk * 64, smem);
  }
  stage_wf(p.w_in, smem);
  const int lane = t & 63, w = t >> 6;
#pragma unroll 1
  for (int row = bid * 4 + w; row < T; row += nb * 4) {
    f32x4 xv[4];
#pragma unroll
    for (int pp = 0; pp < 4; ++pp) xv[pp] = __builtin_nontemporal_load((const f32x4*)(p.x + (size_t)row * 1024 + 256 * pp + 4 * lane));
    prenorm_row(xv, p.gpre, (const float*)smem, p.fbias, (bf16_t*)(ws + OFF_H), (float*)(ws + OFF_LF), row, lane);
  }
  __syncthreads();
}

DI void phase_inproj(const Params& p, int layer, char* smem, int* s_item, const int var = 0) {
  unsigned char* ws = p.ws;
  for (int seq = blockIdx.x; seq < 32; seq += gridDim.x) cumsum_item((const float*)(ws + OFF_LF), (float*)(ws + OFF_CUM), seq, smem);
  if (var != 0) {
    for (int ti = blockIdx.x; ti < 64 * 48; ti += gridDim.x) {
      int mt, nt;
      tile_coords(ti, 8, mt, nt);
      inproj_tile(p, layer, mt, nt, smem, var);
    }
    return;
  }
  unsigned* ctr = (unsigned*)(ws + OFF_CTR) + 16 + layer * 8;
  const int home = (int)(xb_xcc_id() & 7u);
  const int t = tid_opaque();
  int cur = home, pend = 0;
  if (t == 0) pend = (int)atomicAdd(ctr + cur, 1u);
  for (;;) {
    if (t == 0) {
      int code = -1;
      for (;;) {
        if (pend < 384) { code = (cur << 16) | pend; break; }
        int best = 99, nxt = -1;
#pragma unroll
        for (int x = 0; x < 8; ++x) {
          const unsigned cx = xb_ld(ctr + x);
          const int d = (x - home) & 7;
          if (cx < 384u && d < best) { best = d; nxt = x; }
        }
        if (nxt < 0) break;
        cur = nxt;
        pend = (int)atomicAdd(ctr + cur, 1u);
      }
      *s_item = code;
    }
    __syncthreads();
    const int code = *s_item;
    __syncthreads();
    if (code < 0) break;
    if (t == 0) pend = (int)atomicAdd(ctr + cur, 1u);
    const int xq = code >> 16, q = code & 0xffff;
    const int ti = (5 - (q >> 6)) * 512 + (q & 63) * 8 + xq;
    int mt, nt;
    tile_coords(ti, 8, mt, nt);
    inproj_tile(p, layer, mt, nt, smem, 0);
  }
}

DI void phase_attn(const Params& p, int layer, char* smem, int* s_item, const int ctr_base = 0, const int type_mask = 7, bf16_t* gbase = nullptr, const int var = 0) {
  unsigned* ctr = (unsigned*)(p.ws + OFF_CTR) + ctr_base + layer * 8;
  if (gbase == nullptr) gbase = (bf16_t*)(p.ws + OFF_G);
  const int home = (int)(xb_xcc_id() & 7u);
  const int t = tid_opaque();
  int step = 0, pend = 0;
  if (t == 0) pend = (int)atomicAdd(ctr + (home & 7), 1u);
  for (;;) {
    if (t == 0) {
      int code = -1;
      while (step < 8) {
        if (pend < 384) { code = (((home + step) & 7) << 16) | pend; break; }
        ++step;
        if (step < 8) pend = (int)atomicAdd(ctr + ((home + step) & 7), 1u);
      }
      *s_item = code;
    }
    __syncthreads();
    const int code = *s_item;
    __syncthreads();
    if (code < 0) break;
    if (t == 0) pend = (int)atomicAdd(ctr + ((home + step) & 7), 1u);
    int type, bh, qb;
    if (!decode_item(code >> 16, code & 0xffff, type, bh, qb)) break;
    if (!((type_mask >> type) & 1)) continue;
    if (type == 0) attn_softmax_item<true>(p, layer, bh >> 2, bh & 3, qb, smem, gbase, var);
    else if (type == 1) attn_sb_item(p, bh >> 3, bh & 7, qb, smem, gbase);
    else attn_softmax_item<false>(p, layer, bh >> 3, bh & 7, qb, smem, gbase, var);
  }
  if (layer == 0 && ctr_base == 0) {
    unsigned* tctr = (unsigned*)(p.ws + OFF_CTR) + 60;
    for (;;) {
      if (t == 0) *s_item = (int)atomicAdd(tctr, 1u);
      __syncthreads();
      const int it = *s_item;
      __syncthreads();
      if (it >= 768 + 1536) break;
      if (it < 768) {
        const int lay = it / 384, jj = it % 384;
        const int nblk = jj % 16, kblk = jj / 16;
        transpose_tile(p.w_out + (size_t)lay * 1536 * 1024, 1024, (bf16_t*)(p.ws + OFF_WOUTT) + (size_t)lay * 1024 * 1536, 1536, kblk * 64, nblk * 64, smem);
      } else {
        const int j = it - 768;
        const int nblk = j % 96, kblk = j / 96;
        transpose_tile(p.w_in + (size_t)1024 * DIN, DIN, (bf16_t*)(p.ws + OFF_WINT), 1024, kblk * 64, nblk * 64, smem);
      }
    }
  }
}

DI void phase_outproj(const Params& p, int layer, char* smem) {
  for (int ti = blockIdx.x; ti < 64 * 8; ti += gridDim.x) {
    int mt, nt;
    tile_coords(ti, 8, mt, nt);
    outproj_tile(p, layer, mt, nt, smem);
  }
}

DI void phase_postnorm(const Params& p, int layer, char* smem) {
  unsigned char* ws = p.ws;
  const int t = tid_opaque(), lane = t & 63, w = t >> 6;
  if (layer == 0) stage_wf(p.w_in + (size_t)1024 * DIN, smem);
  const bf16_t* y = (const bf16_t*)(ws + OFF_QKV);
  const float* xin = (layer == 0) ? p.x : p.out;
  const float* gpost = p.gpost + layer * 1024;
#pragma unroll 1
  for (int row = blockIdx.x * 4 + w; row < T; row += gridDim.x * 4) {
    f32x4 yv[4], xv[4];
    float ss = 0.f;
#pragma unroll
    for (int pp = 0; pp < 4; ++pp) {
      const u32x2 yb = __builtin_nontemporal_load((const u32x2*)(y + (size_t)row * 1024 + 256 * pp + 4 * lane));
      yv[pp][0] = bflo(yb[0]); yv[pp][1] = bfhi(yb[0]); yv[pp][2] = bflo(yb[1]); yv[pp][3] = bfhi(yb[1]);
      xv[pp] = __builtin_nontemporal_load((const f32x4*)(xin + (size_t)row * 1024 + 256 * pp + 4 * lane));
#pragma unroll
      for (int i = 0; i < 4; ++i) ss += yv[pp][i] * yv[pp][i];
    }
    ss = wave_sum(ss);
    const float rinv = rsqrtf(ss * (1.f / 1024.f) + NORM_EPS);
#pragma unroll
    for (int pp = 0; pp < 4; ++pp) {
      const f32x4 g = *(const f32x4*)(gpost + 256 * pp + 4 * lane);
#pragma unroll
      for (int i = 0; i < 4; ++i) xv[pp][i] += yv[pp][i] * rinv * g[i];
      *(f32x4*)(p.out + (size_t)row * 1024 + 256 * pp + 4 * lane) = xv[pp];
    }
    if (layer == 0)
      prenorm_row(xv, p.gpre + 1024, (const float*)smem, p.fbias + 8, (bf16_t*)(ws + OFF_H), (float*)(ws + OFF_LF), row, lane);
  }
  __syncthreads();
}

__global__ void __launch_bounds__(256, 2) fwd_kernel(Params p) {
  __shared__ __attribute__((aligned(1024))) char smem[SMEM_BYTES];
  __shared__ uint4 xb_words;
  __shared__ int s_item;
  if (tid_opaque() == 0) xb_words = make_uint4(0u, 0u, 0u, 0u);
  __syncthreads();
  (void)xcd_barrier_post((unsigned*)(p.ws + OFF_BAR), (volatile LAS unsigned*)&xb_words);
  if (p.ws == nullptr) cg::this_grid().sync();
  for (int rep = 0; rep < (DUP_PHASE == 0 ? 2 : 1); ++rep) { phase_setup(p, smem); xcd_barrier(p, (volatile LAS unsigned*)&xb_words); }
#pragma unroll 1
  for (int layer = 0; layer < 2; ++layer) {
    for (int rep = 0; rep < (DUP_PHASE == 1 ? 2 - layer : 1); ++rep) { phase_inproj(p, layer, smem, &s_item, rep ? EXP_VAR : 0); xcd_barrier(p, (volatile LAS unsigned*)&xb_words); }
    phase_attn(p, layer, smem, &s_item);
    xcd_barrier(p, (volatile LAS unsigned*)&xb_words);
    if (DUP_PHASE == 2 && layer == 0) { phase_attn(p, layer, smem, &s_item, 32, EXP_VAR & 7, (bf16_t*)p.out, EXP_VAR >> 3); xcd_barrier(p, (volatile LAS unsigned*)&xb_words); }
    for (int rep = 0; rep < (DUP_PHASE == 3 ? 2 - layer : 1); ++rep) { phase_outproj(p, layer, smem); xcd_barrier(p, (volatile LAS unsigned*)&xb_words); }
    for (int rep = 0; rep < (DUP_PHASE == 4 ? 2 - layer : 1); ++rep) { phase_postnorm(p, layer, smem); if (layer == 0) xcd_barrier(p, (volatile LAS unsigned*)&xb_words); }
  }
}

extern "C" void kernel_launch(void* const* d_in, const int* in_sizes, int n_in, void* d_out, int out_size, void* d_ws, size_t ws_size,
                              hipStream_t stream) {
  static int grid_blocks = 0;
  if (!grid_blocks) {
    int dev = 0, cus = 0, per_cu = 0;
    (void)hipGetDevice(&dev);
    (void)hipDeviceGetAttribute(&cus, hipDeviceAttributeMultiprocessorCount, dev);
    (void)hipOccupancyMaxActiveBlocksPerMultiprocessor(&per_cu, fwd_kernel, 256, 0);
    if (per_cu > 2) per_cu = 2;
    if (per_cu < 1) per_cu = 1;
    grid_blocks = cus * per_cu;
    if (ws_size < WS_NEED) fprintf(stderr, "workspace too small: %zu < %zu\n", ws_size, WS_NEED);
  }
  Params p{};
  p.x = (const float*)d_in[0]; p.w_in = (const float*)d_in[1]; p.fbias = (const float*)d_in[2]; p.dlam = (const float*)d_in[3];
  p.subln = (const float*)d_in[4]; p.w_out = (const float*)d_in[5]; p.gpre = (const float*)d_in[6]; p.gpost = (const float*)d_in[7];
  p.out = (float*)d_out; p.ws = (unsigned char*)d_ws;
  (void)hipMemsetAsync((unsigned char*)d_ws + OFF_BAR, 0, XCD_BAR_WORDS * 4, stream);
  void* args[] = {&p};
  hipError_t e = hipLaunchCooperativeKernel((void*)fwd_kernel, dim3(grid_blocks), dim3(256), args, 0, stream);
  if (e != hipSuccess) fprintf(stderr, "cooperative launch failed: %s (grid %d)\n", hipGetErrorString(e), grid_blocks);
}
```

```cpp
#include <hip/hip_runtime.h>
#include <hip/hip_cooperative_groups.h>
#include <cstdio>
namespace cg = cooperative_groups;

#ifndef EXP_VAR
#define EXP_VAR 0
#endif
#ifndef DUP_PHASE
#define DUP_PHASE -1
#endif

typedef unsigned short bf16_t;
typedef short bf16x8 __attribute__((ext_vector_type(8)));
typedef float f32x16 __attribute__((ext_vector_type(16)));
typedef float f32x4 __attribute__((ext_vector_type(4)));
typedef float f32x2 __attribute__((ext_vector_type(2)));
typedef __bf16 bf16x2n __attribute__((ext_vector_type(2)));
typedef unsigned u32x2 __attribute__((ext_vector_type(2)));
typedef unsigned u32x4 __attribute__((ext_vector_type(4)));

#define DI __device__ __forceinline__
#define MFMA32(a, b, c) __builtin_amdgcn_mfma_f32_32x32x16_bf16((a), (b), (c), 0, 0, 0)

constexpr int T = 16384, S = 4096, D = 1024, DIN = 6152, DMIX = 1536;
constexpr int LROW = 72;
constexpr float LOG2E = 1.4426950408889634f;
constexpr float NORM_EPS = 1e-6f;
constexpr int SMEM_BYTES = 73728;

constexpr size_t OFF_WINT = 0;
constexpr size_t OFF_WOUTT = OFF_WINT + (size_t)6144 * 1024 * 2;
constexpr size_t OFF_H = OFF_WOUTT + (size_t)2 * 1024 * 1536 * 2;
constexpr size_t OFF_QKV = OFF_H + (size_t)T * 1024 * 2;
constexpr size_t TENS = (size_t)T * 512;
constexpr size_t OFF_G = OFF_QKV + 9 * TENS * 2;
constexpr size_t OFF_LF = OFF_G + (size_t)T * 1536 * 2;
constexpr size_t OFF_CUM = OFF_LF + (size_t)32 * 4096 * 4;
constexpr size_t OFF_ROPE = OFF_CUM + (size_t)32 * 4096 * 4;
constexpr size_t OFF_CTR = OFF_ROPE + (size_t)2 * 4096 * 8 * 4;
constexpr size_t OFF_KMAX = OFF_CTR + 1024;
constexpr size_t OFF_BAR = OFF_CTR + 4096;
constexpr size_t WS_NEED = OFF_BAR + 16384;

struct Params {
  const float* x; const float* w_in; const float* fbias; const float* dlam; const float* subln;
  const float* w_out; const float* gpre; const float* gpost; float* out; unsigned char* ws;
};

DI int tid_opaque() { int t = threadIdx.x; asm volatile("" : "+v"(t)); return t; }
DI int bid_opaque() { int b = blockIdx.x; asm volatile("" : "+s"(b)); return b; }
DI unsigned pk2(float a, float b) { f32x2 v = {a, b}; bf16x2n r = __builtin_convertvector(v, bf16x2n); return __builtin_bit_cast(unsigned, r); }
DI float bflo(unsigned u) { return __uint_as_float(u << 16); }
DI float bfhi(unsigned u) { return __uint_as_float(u & 0xffff0000u); }
DI float wave_sum(float v) {
#pragma unroll
  for (int o = 32; o; o >>= 1) v += __shfl_xor(v, o);
  return v;
}
DI float xhalf(float v) { return __shfl_xor(v, 32); }
DI float xmax(float v) {
  auto r = __builtin_amdgcn_permlane32_swap(__float_as_uint(v), __float_as_uint(v), false, false);
  return fmaxf(__uint_as_float(r[0]), __uint_as_float(r[1]));
}
DI float xsum(float v) {
  auto r = __builtin_amdgcn_permlane32_swap(__float_as_uint(v), __float_as_uint(v), false, false);
  return __uint_as_float(r[0]) + __uint_as_float(r[1]);
}
DI void xboth(float v, float& lo, float& hi) {
  auto r = __builtin_amdgcn_permlane32_swap(__float_as_uint(v), __float_as_uint(v), false, false);
  lo = __uint_as_float(r[0]); hi = __uint_as_float(r[1]);
}
DI u32x4 swap_pair(u32x2 pe, u32x2 po) {
  auto r0 = __builtin_amdgcn_permlane32_swap(pe[0], po[0], false, false);
  auto r1 = __builtin_amdgcn_permlane32_swap(pe[1], po[1], false, false);
  u32x4 o = {r0[0], r1[0], r0[1], r1[1]};
  return o;
}
DI bf16x8 pack8(float a0, float a1, float a2, float a3, float a4, float a5, float a6, float a7) {
  u32x4 u = {pk2(a0, a1), pk2(a2, a3), pk2(a4, a5), pk2(a6, a7)};
  return __builtin_bit_cast(bf16x8, u);
}
DI float log_sigmoid_f(float v) { return fminf(v, 0.f) - __logf(1.f + __expf(-fabsf(v))); }

DI void transpose_tile(const float* __restrict__ src, int ldn, bf16_t* __restrict__ dst, int K, int k0, int n0, char* smem) {
  float* tile = (float*)smem;
  const int t = tid_opaque();
#pragma unroll
  for (int p = 0; p < 16; ++p) {
    const int k = p * 4 + (t >> 6), n = t & 63;
    tile[k * 65 + n] = src[(size_t)(k0 + k) * ldn + n0 + n];
  }
  __syncthreads();
#pragma unroll
  for (int p = 0; p < 8; ++p) {
    const int n = p * 8 + (t >> 5), k = (t & 31) * 2;
    *(unsigned*)(dst + (size_t)(n0 + n) * K + k0 + k) = pk2(tile[k * 65 + n], tile[(k + 1) * 65 + n]);
  }
  __syncthreads();
}

DI void stage_wf(const float* __restrict__ w_in_l, char* smem) {
  float* wf = (float*)smem;
  const int t0 = tid_opaque();
  for (int e = t0; e < 2048; e += 256) {
    const int k = e >> 1, half = e & 1;
    const f32x4 v = *(const f32x4*)(w_in_l + (size_t)k * DIN + 6144 + half * 4);
#pragma unroll
    for (int i = 0; i < 4; ++i) wf[(half * 4 + i) * 1024 + k] = v[i];
  }
  __syncthreads();
}

DI void prenorm_row(const f32x4 (&xv)[4], const float* __restrict__ gpre, const float* wf, const float* __restrict__ fbias,
                    bf16_t* __restrict__ hbuf, float* __restrict__ lf, int tok, int lane) {
  float ss = 0.f;
#pragma unroll
  for (int p = 0; p < 4; ++p)
#pragma unroll
    for (int i = 0; i < 4; ++i) ss += xv[p][i] * xv[p][i];
  ss = wave_sum(ss);
  const float rinv = rsqrtf(ss * (1.f / 1024.f) + NORM_EPS);
  float ff[8];
#pragma unroll
  for (int hh = 0; hh < 8; ++hh) ff[hh] = 0.f;
#pragma unroll
  for (int p = 0; p < 4; ++p) {
    const f32x4 g = *(const f32x4*)(gpre + 256 * p + 4 * lane);
    f32x4 hv;
#pragma unroll
    for (int i = 0; i < 4; ++i) hv[i] = xv[p][i] * rinv * g[i];
    u32x2 st = {pk2(hv[0], hv[1]), pk2(hv[2], hv[3])};
    *(u32x2*)(hbuf + (size_t)tok * 1024 + 256 * p + 4 * lane) = st;
#pragma unroll
    for (int hh = 0; hh < 8; ++hh) {
      const f32x4 w = *(const f32x4*)(wf + hh * 1024 + 256 * p + 4 * lane);
      ff[hh] += hv[0] * w[0] + hv[1] * w[1] + hv[2] * w[2] + hv[3] * w[3];
    }
    __builtin_amdgcn_sched_barrier(0);
  }
  float mine = 0.f;
#pragma unroll
  for (int hh = 0; hh < 8; ++hh) {
    const float s = wave_sum(ff[hh]);
    if (lane == hh) mine = s;
  }
  if (lane < 8) lf[((size_t)(tok >> 12) * 8 + lane) * 4096 + (tok & 4095)] = log_sigmoid_f(mine + fbias[lane]);
}

DI void cumsum_item(const float* __restrict__ lf, float* __restrict__ cum, int seq, char* smem) {
  float* sm = (float*)smem;
  const int t = tid_opaque(), lane = t & 63, w = t >> 6;
  float v[16];
#pragma unroll
  for (int p = 0; p < 4; ++p) {
    const f32x4 a = *(const f32x4*)(lf + (size_t)seq * 4096 + 16 * t + 4 * p);
#pragma unroll
    for (int i = 0; i < 4; ++i) v[4 * p + i] = a[i];
  }
#pragma unroll
  for (int i = 1; i < 16; ++i) v[i] += v[i - 1];
  float tot = v[15];
  float inc = tot;
#pragma unroll
  for (int o = 1; o < 64; o <<= 1) { const float n = __shfl_up(inc, o); if (lane >= o) inc += n; }
  if (lane == 63) sm[w] = inc;
  __syncthreads();
  float base = inc - tot;
  for (int i = 0; i < w; ++i) base += sm[i];
#pragma unroll
  for (int p = 0; p < 4; ++p) {
    f32x4 a;
#pragma unroll
    for (int i = 0; i < 4; ++i) a[i] = (v[4 * p + i] + base) * LOG2E;
    *(f32x4*)(cum + (size_t)seq * 4096 + 16 * t + 4 * p) = a;
  }
  __syncthreads();
}

constexpr int GA_BYTES = 256 * 64, GB_BYTES = 128 * 64, GSTAGE = GA_BYTES + GB_BYTES;
typedef __attribute__((address_space(3))) void* lds_vp;
typedef const __attribute__((address_space(1))) void* glb_vp;
DI void glds16(const char* g, char* lds_wave_base) {
  __builtin_amdgcn_global_load_lds((glb_vp)(unsigned long long)g, (lds_vp)(unsigned)(unsigned long long)lds_wave_base, 16, 0, 0);
}
template <bool TR>
DI void gemm_mainloop(const int t, const bf16_t* __restrict__ A, int lda, const bf16_t* __restrict__ B, int ldb, int K, char* smem, f32x16 (&acc)[4][2], const int var = 0) {
  const int lane = t & 63, w = t >> 6, wm = w >> 1, wn = w & 1, r = lane & 31, h = lane >> 5;
  const int wu = __builtin_amdgcn_readfirstlane(w);
  const int srow = lane >> 2, schunk = (lane & 3) ^ ((lane >> 4) & 3);
  unsigned aoff[4], boff[2];
#pragma unroll
  for (int p = 0; p < 4; ++p) aoff[p] = (unsigned)((((p * 4 + wu) * 16 + srow) * lda + schunk * 8) * 2);
#pragma unroll
  for (int p = 0; p < 2; ++p) boff[p] = (unsigned)((((p * 4 + wu) * 16 + srow) * ldb + schunk * 8) * 2);
  const char* Ab = (const char*)A;
  const char* Bb = (const char*)B;
  char* dA = smem + wu * 1024;
  char* dB = smem + GA_BYTES + wu * 1024;
#pragma unroll
  for (int p = 0; p < 4; ++p) glds16(Ab + aoff[p], dA + p * 4096);
#pragma unroll
  for (int p = 0; p < 2; ++p) glds16(Bb + boff[p], dB + p * 4096);
  const int fsw = (h ^ ((r >> 2) & 3)) * 16;
  const int fa0 = (wm * 128 + r) * 64 + fsw, fa1 = fa0 ^ 32;
  const int fb0 = GA_BYTES + (wn * 64 + r) * 64 + fsw, fb1 = fb0 ^ 32;
  asm volatile("s_waitcnt vmcnt(0)" ::: "memory");
  __syncthreads();
  const int nk = K >> 5;
  const bool skip = (var & 2) != 0;
  for (int kt = 0; kt < nk; ++kt) {
    const int buf = kt & 1;
    if (kt + 1 < nk && !skip) {
      Ab += 64; Bb += 64;
      char* nA = dA + (buf ^ 1) * GSTAGE;
      char* nB = dB + (buf ^ 1) * GSTAGE;
#pragma unroll
      for (int p = 0; p < 4; ++p) glds16(Ab + aoff[p], nA + p * 4096);
#pragma unroll
      for (int p = 0; p < 2; ++p) glds16(Bb + boff[p], nB + p * 4096);
    }
    const char* sb = smem + buf * GSTAGE;
    bf16x8 a0[4], b0[2], a1[4], b1[2];
#pragma unroll
    for (int i = 0; i < 4; ++i) a0[i] = *(const bf16x8*)(sb + fa0 + i * 2048);
#pragma unroll
    for (int j = 0; j < 2; ++j) b0[j] = *(const bf16x8*)(sb + fb0 + j * 2048);
    __builtin_amdgcn_sched_barrier(0);
#pragma unroll
    for (int i = 0; i < 4; ++i) a1[i] = *(const bf16x8*)(sb + fa1 + i * 2048);
#pragma unroll
    for (int j = 0; j < 2; ++j) b1[j] = *(const bf16x8*)(sb + fb1 + j * 2048);
#pragma unroll
    for (int i = 0; i < 4; ++i)
#pragma unroll
      for (int j = 0; j < 2; ++j) {
        if (!TR) acc[i][j] = MFMA32(a0[i], b0[j], acc[i][j]);
        else acc[i][j] = MFMA32(b0[j], a0[i], acc[i][j]);
      }
#pragma unroll
    for (int i = 0; i < 4; ++i)
#pragma unroll
      for (int j = 0; j < 2; ++j) {
        if (!TR) acc[i][j] = MFMA32(a1[i], b1[j], acc[i][j]);
        else acc[i][j] = MFMA32(b1[j], a1[i], acc[i][j]);
      }
#pragma unroll
    for (int g = 0; g < 6; ++g) {
      __builtin_amdgcn_sched_group_barrier(0x008, 1, 0);
      __builtin_amdgcn_sched_group_barrier(0x100, 1, 0);
    }
    __builtin_amdgcn_sched_group_barrier(0x008, 10, 0);
    __builtin_amdgcn_sched_barrier(0);
    asm volatile("s_waitcnt vmcnt(0)" ::: "memory");
    __syncthreads();
  }
}

DI void zero_acc(f32x16 (&acc)[4][2]) {
#pragma unroll
  for (int i = 0; i < 4; ++i)
#pragma unroll
    for (int j = 0; j < 2; ++j)
#pragma unroll
      for (int e = 0; e < 16; ++e) acc[i][j][e] = 0.f;
}

DI void tile_coords(int tidx, int n_super_m, int& mt, int& nt) {
  const int j = tidx >> 9, bb = tidx & 511, xcd = bb & 7, local = bb >> 3;
  const int st = j * 8 + xcd;
  const int sm = st % n_super_m, sn = st / n_super_m;
  mt = sm * 8 + (local & 7);
  nt = sn * 8 + (local >> 3);
}

DI void inproj_tile(const Params& p, int layer, int mt, int nt, char* smem, const int var = 0) {
  unsigned char* ws = p.ws;
  const bf16_t* hb = (const bf16_t*)(ws + OFF_H) + (size_t)mt * 256 * 1024;
  const bf16_t* wb = (const bf16_t*)(ws + OFF_WINT) + (size_t)nt * 128 * 1024;
  const int t = tid_opaque(), lane = t & 63, w = t >> 6, wm = w >> 1, wn = w & 1, r = lane & 31, h = lane >> 5;
  const int split = nt >> 2, kind = split & 3, grp = split >> 2;
  f32x16 acc[4][2];
  zero_acc(acc);
  if (kind == 2) {
    gemm_mainloop<false>(t, hb, 1024, wb, 1024, 1024, smem, acc, var);
    if ((var & 1) && acc[0][0][0] != 12345.678f) return;
    bf16_t* tens = (bf16_t*)(ws + OFF_QKV) + (size_t)(grp * 3 + 2) * TENS;
    const int b = (mt * 256) >> 12, sbase = (mt * 256) & 4095;
#pragma unroll
    for (int j = 0; j < 2; ++j) {
      bf16_t* hp;
      int dv, DV;
      if (grp == 0) { hp = tens + (size_t)(b * 4 + (nt & 3)) * 4096 * 128; dv = wn * 64 + j * 32 + r; DV = 128; }
      else { hp = tens + (size_t)(b * 8 + (nt & 3) * 2 + wn) * 4096 * 64; dv = j * 32 + r; DV = 64; }
#pragma unroll
      for (int i = 0; i < 4; ++i)
#pragma unroll
        for (int g = 0; g < 4; g += 2) {
          const int s0 = sbase + wm * 128 + i * 32 + 8 * (g + h);
          u32x2 pe = {pk2(acc[i][j][4 * g], acc[i][j][4 * g + 1]), pk2(acc[i][j][4 * g + 2], acc[i][j][4 * g + 3])};
          u32x2 po = {pk2(acc[i][j][4 * g + 4], acc[i][j][4 * g + 5]), pk2(acc[i][j][4 * g + 6], acc[i][j][4 * g + 7])};
          *(u32x4*)(hp + ((size_t)((s0 >> 6) * DV + dv)) * 64 + (s0 & 63)) = swap_pair(pe, po);
        }
    }
  } else {
    gemm_mainloop<true>(t, hb, 1024, wb, 1024, 1024, smem, acc, var);
    if ((var & 1) && acc[0][0][0] != 12345.678f) return;
#pragma unroll
    for (int i = 0; i < 4; ++i) {
      const int tok = mt * 256 + wm * 128 + i * 32 + r;
      const int b = tok >> 12, s = tok & 4095;
      if (kind == 3) {
        bf16_t* gp = (bf16_t*)(ws + OFF_G) + (size_t)tok * 1536 + grp * 512 + (nt & 3) * 128 + wn * 64 + 8 * h;
#pragma unroll
        for (int j = 0; j < 2; ++j)
#pragma unroll
          for (int g = 0; g < 4; g += 2) {
            float v[8];
#pragma unroll
            for (int e = 0; e < 8; ++e) { const float a = acc[i][j][4 * g + e]; v[e] = a * __builtin_amdgcn_rcpf(1.f + __expf(-a)); }
            u32x2 pe = {pk2(v[0], v[1]), pk2(v[2], v[3])};
            u32x2 po = {pk2(v[4], v[5]), pk2(v[6], v[7])};
            *(u32x4*)(gp + j * 32 + 8 * g) = swap_pair(pe, po);
          }
      } else {
        const int hh = (nt & 3) * 2 + wn;
        if (grp == 2 && kind == 1) {
          float ss = 0.f;
#pragma unroll
          for (int j = 0; j < 2; ++j)
#pragma unroll
            for (int e = 0; e < 16; ++e) ss += acc[i][j][e] * acc[i][j][e];
          ss = xsum(ss);
#pragma unroll
          for (int o2 = 16; o2; o2 >>= 1) ss = fmaxf(ss, __shfl_xor(ss, o2));
          if (lane == 0) atomicMax((unsigned*)(ws + OFF_KMAX) + layer * 32 + b * 8 + hh, __float_as_uint(ss));
        }
        bf16_t* qp = (bf16_t*)(ws + OFF_QKV) + (size_t)(grp * 3 + kind) * TENS + ((size_t)(b * 8 + hh) * 4096 + s) * 64 + 8 * h;
        const float sc = (kind == 0) ? (grp == 1 ? -0.125f * LOG2E : 0.125f * LOG2E) : 1.f;
        f32x16 a0 = acc[i][0];
        if (grp == 0) {
          const f32x4 cs = *(const f32x4*)((const float*)(ws + OFF_ROPE) + s * 8 + 4 * h);
          const f32x4 sn = *(const f32x4*)((const float*)(ws + OFF_ROPE) + 4096 * 8 + s * 8 + 4 * h);
#pragma unroll
          for (int e = 0; e < 4; ++e) {
            const float r1 = a0[e], r2 = a0[4 + e];
            a0[e] = r1 * cs[e] - r2 * sn[e];
            a0[4 + e] = r2 * cs[e] + r1 * sn[e];
          }
        }
#pragma unroll
        for (int j = 0; j < 2; ++j)
#pragma unroll
          for (int g = 0; g < 4; g += 2) {
            float v[8];
#pragma unroll
            for (int e = 0; e < 8; ++e) v[e] = (j == 0 ? a0[4 * g + e] : acc[i][1][4 * g + e]) * sc;
            u32x2 pe = {pk2(v[0], v[1]), pk2(v[2], v[3])};
            u32x2 po = {pk2(v[4], v[5]), pk2(v[6], v[7])};
            *(u32x4*)(qp + j * 32 + 8 * g) = swap_pair(pe, po);
          }
      }
    }
  }
}

DI void outproj_tile(const Params& p, int layer, int mt, int nt, char* smem) {
  unsigned char* ws = p.ws;
  const bf16_t* ab = (const bf16_t*)(ws + OFF_G) + (size_t)mt * 256 * 1536;
  const bf16_t* wb = (const bf16_t*)(ws + OFF_WOUTT) + (size_t)layer * 1024 * 1536 + (size_t)nt * 128 * 1536;
  const int t = tid_opaque(), lane = t & 63, w = t >> 6, wm = w >> 1, wn = w & 1, r = lane & 31, h = lane >> 5;
  f32x16 acc[4][2];
  zero_acc(acc);
  gemm_mainloop<true>(t, ab, 1536, wb, 1536, 1536, smem, acc);
  bf16_t* y = (bf16_t*)(ws + OFF_QKV);
#pragma unroll
  for (int i = 0; i < 4; ++i) {
    const int tok = mt * 256 + wm * 128 + i * 32 + r;
    bf16_t* yp = y + (size_t)tok * 1024 + nt * 128 + wn * 64 + 8 * h;
#pragma unroll
    for (int j = 0; j < 2; ++j)
#pragma unroll
      for (int g = 0; g < 4; g += 2) {
        u32x2 pe = {pk2(acc[i][j][4 * g], acc[i][j][4 * g + 1]), pk2(acc[i][j][4 * g + 2], acc[i][j][4 * g + 3])};
        u32x2 po = {pk2(acc[i][j][4 * g + 4], acc[i][j][4 * g + 5]), pk2(acc[i][j][4 * g + 6], acc[i][j][4 * g + 7])};
        *(u32x4*)(yp + j * 32 + 8 * g) = swap_pair(pe, po);
      }
  }
}

DI int pi_row(int r) { return (r & 0x13) | ((r & 4) << 1) | ((r & 8) >> 1); }

template <int NR>
DI void tile_gload(const int t, const bf16_t* __restrict__ g, size_t gstride, u32x4* regs) {
  const int lrow = t >> 3, lch = t & 7;
#pragma unroll
  for (int p = 0; p < NR / 32; ++p) regs[p] = *(const u32x4*)(g + (size_t)(lrow + 32 * p) * gstride + lch * 8);
}
template <int NR>
DI void tile_swrite(const int t, bf16_t* s, const u32x4* regs) {
  const int lrow = t >> 3, lch = t & 7;
#pragma unroll
  for (int p = 0; p < NR / 32; ++p) *(u32x4*)(s + (lrow + 32 * p) * LROW + lch * 8) = regs[p];
}

DI float fmax2(float a, float b) { return __builtin_elementwise_maximum(a, b); }
template <int DVB, bool BIAS, bool MASK>
DI void softmax_tile(const bf16_t* sK, const bf16_t* sV, const float* cb, const bf16x8 (&qf)[4], f32x16 (&o)[DVB], float& m, float& l,
                     int prow, int r, int h, int kbase, int qpos) {
  bf16x8 kf[2][4];
#pragma unroll
  for (int sub = 0; sub < 2; ++sub)
#pragma unroll
    for (int ks = 0; ks < 4; ++ks) kf[sub][ks] = *(const bf16x8*)((const char*)sK + (sub * 32 + prow) * 128 + (((2 * ks + h) ^ ((prow >> 1) & 7)) << 4));
  __builtin_amdgcn_sched_barrier(0);
  f32x16 sc[2];
#pragma unroll
  for (int sub = 0; sub < 2; ++sub) {
    f32x16 z;
#pragma unroll
    for (int e = 0; e < 16; ++e) z[e] = 0.f;
    sc[sub] = MFMA32(kf[sub][0], qf[0], z);
#pragma unroll
    for (int ks = 1; ks < 4; ++ks) sc[sub] = MFMA32(kf[sub][ks], qf[ks], sc[sub]);
  }
  bf16x8 vf[2][4];
#pragma unroll
  for (int mb = 0; mb < 2; ++mb)
#pragma unroll
    for (int f = 0; f < 4; ++f) vf[mb][f] = *(const bf16x8*)((const char*)sV + (mb * 32 + r) * 128 + (((2 * f + h) ^ ((r >> 1) & 7)) << 4));
  if (BIAS) {
#pragma unroll
    for (int sub = 0; sub < 2; ++sub)
#pragma unroll
      for (int s2 = 0; s2 < 2; ++s2) {
        const f32x4 c0 = *(const f32x4*)(cb + sub * 32 + s2 * 16 + 8 * h);
        const f32x4 c1 = *(const f32x4*)(cb + sub * 32 + s2 * 16 + 8 * h + 4);
#pragma unroll
        for (int e = 0; e < 4; ++e) {
          sc[sub][8 * s2 + e] -= c0[e];
          sc[sub][8 * s2 + 4 + e] -= c1[e];
        }
      }
  }
  if (MASK) {
#pragma unroll
    for (int sub = 0; sub < 2; ++sub)
#pragma unroll
      for (int e = 0; e < 16; ++e) {
        const int key = kbase + sub * 32 + (e >> 3) * 16 + 8 * h + (e & 7);
        if (key > qpos) sc[sub][e] = -INFINITY;
      }
  }
  float mx = fmax2(sc[0][0], sc[1][0]);
#pragma unroll
  for (int e = 1; e < 16; ++e) mx = fmax2(fmax2(mx, sc[0][e]), sc[1][e]);
  mx = xmax(mx);
  if (__any(mx > m + 8.f)) {
    const float mn = fmaxf(m, mx);
    const float alpha = __builtin_amdgcn_exp2f(m - mn);
    m = mn;
    l *= alpha;
#pragma unroll
    for (int mb = 0; mb < DVB; ++mb)
#pragma unroll
      for (int e = 0; e < 16; ++e) o[mb][e] *= alpha;
  }
  float ls = 0.f;
  bf16x8 pf[4];
#pragma unroll
  for (int sub = 0; sub < 2; ++sub) {
#pragma unroll
    for (int e = 0; e < 16; ++e) { sc[sub][e] = __builtin_amdgcn_exp2f(sc[sub][e] - m); ls += sc[sub][e]; }
    pf[sub * 2 + 0] = pack8(sc[sub][0], sc[sub][1], sc[sub][2], sc[sub][3], sc[sub][4], sc[sub][5], sc[sub][6], sc[sub][7]);
    pf[sub * 2 + 1] = pack8(sc[sub][8], sc[sub][9], sc[sub][10], sc[sub][11], sc[sub][12], sc[sub][13], sc[sub][14], sc[sub][15]);
  }
  l += ls;
#pragma unroll
  for (int mb = 0; mb < 2; ++mb)
#pragma unroll
    for (int f = 0; f < 4; ++f) o[mb] = MFMA32(vf[mb][f], pf[f], o[mb]);
  if (DVB > 2) {
#pragma unroll
    for (int mb = 0; mb < 2; ++mb)
#pragma unroll
      for (int f = 0; f < 4; ++f) vf[mb][f] = *(const bf16x8*)((const char*)sV + ((mb + 2) * 32 + r) * 128 + (((2 * f + h) ^ ((r >> 1) & 7)) << 4));
    __builtin_amdgcn_sched_barrier(0);
#pragma unroll
    for (int mb = 0; mb < 2; ++mb)
#pragma unroll
      for (int f = 0; f < 4; ++f) o[(DVB > 2) ? mb + 2 : mb] = MFMA32(vf[mb][f], pf[f], o[(DVB > 2) ? mb + 2 : mb]);
  }
}

template <bool DIFF>
DI void attn_softmax_item(const Params& p, int layer, int b, int head, int qb, char* smem, bf16_t* gbase, const int var = 0) {
  constexpr int NK = DIFF ? 2 : 1;
  constexpr int DVB = DIFF ? 4 : 2;
  constexpr int VROWS = DVB * 32;
  constexpr int KT_E = 64 * 64, VT_E = VROWS * 64, BUF_E = NK * KT_E + VT_E;
  unsigned char* ws = p.ws;
  bf16_t* sbase = (bf16_t*)smem;
  float* scum = (float*)(smem + 2 * BUF_E * 2);
  const int t = tid_opaque(), lane = t & 63, w = t >> 6, r = lane & 31, h = lane >> 5;
  const int wu = __builtin_amdgcn_readfirstlane(w);
  unsigned soff[4];
#pragma unroll
  for (int pp = 0; pp < 4; ++pp) soff[pp] = (unsigned)((8 * (pp * 4 + wu) + (lane >> 3)) * 128 + (((lane & 7) ^ (((wu & 1) << 2) + ((lane >> 4) & 3))) << 4));
#define ATT_ISSUE(KT, BUF)                                                                                                   \
  {                                                                                                                          \
    char* d_ = smem + (BUF) * (BUF_E * 2) + wu * 1024;                                                                       \
    _Pragma("unroll") for (int c = 0; c < NK; ++c)                                                                           \
      _Pragma("unroll") for (int pp = 0; pp < 2; ++pp)                                                                       \
        glds16((const char*)(Kg[c] + (size_t)(KT) * 64 * 64) + soff[pp], d_ + c * (KT_E * 2) + pp * 4096);                   \
    _Pragma("unroll") for (int pp = 0; pp < VROWS / 32; ++pp)                                                                \
      glds16((const char*)(Vg + (size_t)(KT) * VROWS * 64) + soff[pp], d_ + NK * (KT_E * 2) + pp * 4096);                    \
  }
  const int cw = DIFF ? (w >> 1) : 0;
  const bf16_t* qkv = (const bf16_t*)(ws + OFF_QKV);
  const bf16_t *Qg, *Kg[NK], *Vg;
  if (DIFF) {
#pragma unroll
    for (int c = 0; c < NK; ++c) Kg[c] = qkv + 1 * TENS + (size_t)(b * 8 + head * 2 + c) * 4096 * 64;
    Qg = qkv + 0 * TENS + (size_t)(b * 8 + head * 2 + cw) * 4096 * 64;
    Vg = qkv + 2 * TENS + (size_t)(b * 4 + head) * 128 * 4096;
  } else {
    Qg = qkv + 6 * TENS + (size_t)(b * 8 + head) * 4096 * 64;
    Kg[0] = qkv + 7 * TENS + (size_t)(b * 8 + head) * 4096 * 64;
    Vg = qkv + 8 * TENS + (size_t)(b * 8 + head) * 64 * 4096;
  }
  const float* cumg = (const float*)(ws + OFF_CUM) + (size_t)(b * 8 + head) * 4096;
  const int q0 = DIFF ? (qb * 64 + (w & 1) * 32) : (qb * 128 + w * 32);
  const int qpos = q0 + r;
  bf16x8 qf[4];
#pragma unroll
  for (int ks = 0; ks < 4; ++ks) qf[ks] = *(const bf16x8*)(Qg + (size_t)qpos * 64 + ks * 16 + h * 8);
  f32x16 o[DVB];
  float m = -INFINITY, l = 0.f;
#pragma unroll
  for (int mb = 0; mb < DVB; ++mb)
#pragma unroll
    for (int e = 0; e < 16; ++e) o[mb][e] = 0.f;
  const int ntiles = DIFF ? (qb + 1) : (2 * qb + 2);
  const int last_tile = DIFF ? qb : (2 * qb + (w >> 1));
  const int prow = pi_row(r);
  float qkb = 0.f;
  int* sflag = (int*)(smem + 2 * BUF_E * 2 + 512);
  if (!DIFF) {
    float q2 = 0.f;
#pragma unroll
    for (int ks = 0; ks < 4; ++ks)
#pragma unroll
      for (int e = 0; e < 8; ++e) { const float v = __uint_as_float(((unsigned)(unsigned short)qf[ks][e]) << 16); q2 += v * v; }
    q2 = xsum(q2);
    const float kmax2 = ((const float*)(ws + OFF_KMAX))[layer * 32 + b * 8 + head];
    qkb = sqrtf(q2 * kmax2) * 1.02f + 1.f;
  }
  const int kt0 = DIFF ? 0 : ntiles - 1;
  int wdone = 0;

  float rc = 0.f;
  ATT_ISSUE(kt0, 0)
  if (!DIFF && t < 64) rc = cumg[kt0 * 64 + t];
  asm volatile("s_waitcnt vmcnt(0)" ::: "memory");
  if (!DIFF && t < 64) scum[t] = rc;
  __syncthreads();

  for (int it = 0; it < ntiles; ++it) {
    const int kt = DIFF ? it : ntiles - 1 - it;
    const int kn = DIFF ? it + 1 : kt - 1;
    const bool has_next = (it + 1 < ntiles) && !(var & 1);
    const int buf = it & 1;
    if (has_next) {
      ATT_ISSUE(kn, buf ^ 1)
      if (!DIFF && t < 64) rc = cumg[kn * 64 + t];
    }
    const float* cb = scum + buf * 64;
    if (kt <= last_tile && !wdone && !(var & 2)) {
      const bf16_t* sV = sbase + buf * BUF_E + NK * KT_E;
      const bf16_t* sK = sbase + buf * BUF_E + cw * KT_E;
      if (!DIFF && kt >= 2 * qb) softmax_tile<DVB, !DIFF, true>(sK, sV, cb, qf, o, m, l, prow, r, h, kt * 64, qpos);
      else softmax_tile<DVB, !DIFF, false>(sK, sV, cb, qf, o, m, l, prow, r, h, kt * 64, qpos);
    }
    asm volatile("s_waitcnt vmcnt(0)" ::: "memory");
    if (has_next) {
      if (!DIFF && t < 64) scum[(buf ^ 1) * 64 + t] = rc;
    }
    if (!DIFF) {
      wdone = __all(qkb - cb[0] < m - 138.f);
      if (lane == 0) sflag[buf * 4 + w] = wdone;
    }
    __syncthreads();
    if (!DIFF) {
      if (sflag[buf * 4] & sflag[buf * 4 + 1] & sflag[buf * 4 + 2] & sflag[buf * 4 + 3]) break;
    }
  }
#undef ATT_ISSUE
  if (!DIFF) __syncthreads();

  const int tok = b * 4096 + qpos;
  bf16_t* gp = gbase + (size_t)tok * 1536;
  const float inv = 1.f / xsum(l);
  if (DIFF) {
    float* ex = (float*)smem;
    if (cw == 1) {
#pragma unroll
      for (int mb = 0; mb < DVB; ++mb)
#pragma unroll
        for (int e = 0; e < 16; ++e) ex[(((w & 1) * DVB + mb) * 16 + e) * 64 + lane] = o[mb][e] * inv;
    }
    __syncthreads();
    if (cw == 0) {
      const float* lv = p.dlam + layer * 256;
      float p1 = lv[lane] * lv[64 + lane], p2 = lv[128 + lane] * lv[192 + lane];
      p1 = wave_sum(p1); p2 = wave_sum(p2);
      const float lam_init = 0.2f + (float)layer * (0.6f - 0.6f * 0.74081822068171788f);
      const float lam = expf(p1) - expf(p2) + lam_init;
      float ss = 0.f;
#pragma unroll
      for (int mb = 0; mb < DVB; ++mb)
#pragma unroll
        for (int e = 0; e < 16; ++e) {
          const float v = o[mb][e] * inv - lam * ex[(((w & 1) * DVB + mb) * 16 + e) * 64 + lane];
          o[mb][e] = v;
          ss += v * v;
        }
      ss = xsum(ss);
      const float rn = rsqrtf(ss * (1.f / 128.f) + NORM_EPS) * (1.f - lam_init);
      const float* sg = p.subln + layer * 128;
#pragma unroll
      for (int mb = 0; mb < DVB; ++mb)
#pragma unroll
        for (int g = 0; g < 4; ++g) {
          const int dv = mb * 32 + 8 * g + 4 * h;
          bf16_t* a = gp + head * 128 + dv;
          const u32x2 gt = *(const u32x2*)a;
          const f32x4 gn = *(const f32x4*)(sg + dv);
          const float v0 = o[mb][4 * g] * rn * gn[0] * bflo(gt[0]);
          const float v1 = o[mb][4 * g + 1] * rn * gn[1] * bfhi(gt[0]);
          const float v2 = o[mb][4 * g + 2] * rn * gn[2] * bflo(gt[1]);
          const float v3 = o[mb][4 * g + 3] * rn * gn[3] * bfhi(gt[1]);
          u32x2 st = {pk2(v0, v1), pk2(v2, v3)};
          *(u32x2*)a = st;
        }
    }
    __syncthreads();
  } else {
#pragma unroll
    for (int mb = 0; mb < DVB; ++mb)
#pragma unroll
      for (int g = 0; g < 4; ++g) {
        const int dv = mb * 32 + 8 * g + 4 * h;
        bf16_t* a = gp + 1024 + head * 64 + dv;
        const u32x2 gt = *(const u32x2*)a;
        const float v0 = o[mb][4 * g] * inv * bflo(gt[0]);
        const float v1 = o[mb][4 * g + 1] * inv * bfhi(gt[0]);
        const float v2 = o[mb][4 * g + 2] * inv * bflo(gt[1]);
        const float v3 = o[mb][4 * g + 3] * inv * bfhi(gt[1]);
        u32x2 st = {pk2(v0, v1), pk2(v2, v3)};
        *(u32x2*)a = st;
      }
  }
}

template <bool DIAG>
DI void sb_weights(const f32x16& sc, float& carry, bf16x8& pf0, bf16x8& pf1, int sub, int h, int kbase, int qpos) {
  float beta[16], nb[16];
#pragma unroll
  for (int e = 0; e < 16; ++e) {
    const float u = __builtin_amdgcn_exp2f(sc[e]);
    const float rr = __builtin_amdgcn_rcpf(1.f + u);
    beta[e] = rr;
    nb[e] = 1.f - rr;
  }
  if (DIAG) {
#pragma unroll
    for (int e = 0; e < 16; ++e) {
      const int key = kbase + sub * 32 + (e >> 3) * 16 + 8 * h + (e & 7);
      if (key >= qpos) { beta[e] = 0.f; nb[e] = 1.f; }
    }
  }
  float E[16], Tt[2];
#pragma unroll
  for (int s2 = 0; s2 < 2; ++s2) {
    E[8 * s2 + 7] = 1.f;
#pragma unroll
    for (int j = 6; j >= 0; --j) E[8 * s2 + j] = E[8 * s2 + j + 1] * nb[8 * s2 + j + 1];
    Tt[s2] = E[8 * s2] * nb[8 * s2];
  }
  float T1l, T1h, T0l, T0h;
  xboth(Tt[1], T1l, T1h);
  xboth(Tt[0], T0l, T0h);
  const float c1 = carry * T1h;
  const float c2 = c1 * T1l;
  const float c3 = c2 * T0h;
  const float off1 = h ? carry : c1;
  const float off0 = h ? c2 : c3;
  carry = c3 * T0l;
  float a[16];
#pragma unroll
  for (int e = 0; e < 8; ++e) { a[e] = beta[e] * (E[e] * off0); a[8 + e] = beta[8 + e] * (E[8 + e] * off1); }
  pf0 = pack8(a[0], a[1], a[2], a[3], a[4], a[5], a[6], a[7]);
  pf1 = pack8(a[8], a[9], a[10], a[11], a[12], a[13], a[14], a[15]);
}

template <bool DIAG>
DI void sb_tile(const bf16_t* sK, const bf16_t* sV, const bf16x8 (&qf)[4], f32x16 (&o)[2], float& carry, int prow, int r, int h, int kbase, int qpos) {
  bf16x8 kf[2][4];
#pragma unroll
  for (int sub = 0; sub < 2; ++sub)
#pragma unroll
    for (int ks = 0; ks < 4; ++ks) kf[sub][ks] = *(const bf16x8*)((const char*)sK + (sub * 32 + prow) * 128 + (((2 * ks + h) ^ ((prow >> 1) & 7)) << 4));
  __builtin_amdgcn_sched_barrier(0);
  f32x16 sc[2];
#pragma unroll
  for (int sub = 0; sub < 2; ++sub) {
    f32x16 z;
#pragma unroll
    for (int e = 0; e < 16; ++e) z[e] = 0.f;
    sc[sub] = MFMA32(kf[sub][0], qf[0], z);
#pragma unroll
    for (int ks = 1; ks < 4; ++ks) sc[sub] = MFMA32(kf[sub][ks], qf[ks], sc[sub]);
  }
  bf16x8 vf[2][4];
#pragma unroll
  for (int mb = 0; mb < 2; ++mb)
#pragma unroll
    for (int f = 0; f < 4; ++f) vf[mb][f] = *(const bf16x8*)((const char*)sV + (mb * 32 + r) * 128 + (((2 * f + h) ^ ((r >> 1) & 7)) << 4));
  __builtin_amdgcn_sched_barrier(0);
  bf16x8 pf[4];
  sb_weights<DIAG>(sc[1], carry, pf[2], pf[3], 1, h, kbase, qpos);
  sb_weights<DIAG>(sc[0], carry, pf[0], pf[1], 0, h, kbase, qpos);
#pragma unroll
  for (int mb = 0; mb < 2; ++mb)
#pragma unroll
    for (int f = 0; f < 4; ++f) o[mb] = MFMA32(vf[mb][f], pf[f], o[mb]);
}

DI void attn_sb_item(const Params& p, int b, int head, int qb, char* smem, bf16_t* gbase) {
  constexpr int KT_E = 64 * 64, BUF_E = 2 * KT_E;
  unsigned char* ws = p.ws;
  bf16_t* sbase = (bf16_t*)smem;
  int* sflag = (int*)(smem + 40960);
  const int t = tid_opaque(), lane = t & 63, w = t >> 6, r = lane & 31, h = lane >> 5;
  const int wu = __builtin_amdgcn_readfirstlane(w);
  unsigned soff[2];
#pragma unroll
  for (int pp = 0; pp < 2; ++pp) soff[pp] = (unsigned)((8 * (pp * 4 + wu) + (lane >> 3)) * 128 + (((lane & 7) ^ (((wu & 1) << 2) + ((lane >> 4) & 3))) << 4));
#define SB_ISSUE(KT, BUF)                                                                                     \
  {                                                                                                           \
    char* d_ = smem + (BUF) * (BUF_E * 2) + wu * 1024;                                                        \
    _Pragma("unroll") for (int pp = 0; pp < 2; ++pp) {                                                        \
      glds16((const char*)(Kg + (size_t)(KT) * 64 * 64) + soff[pp], d_ + pp * 4096);                          \
      glds16((const char*)(Vg + (size_t)(KT) * 64 * 64) + soff[pp], d_ + KT_E * 2 + pp * 4096);               \
    }                                                                                                         \
  }
  const bf16_t* qkv = (const bf16_t*)(ws + OFF_QKV);
  const bf16_t* Qg = qkv + 3 * TENS + (size_t)(b * 8 + head) * 4096 * 64;
  const bf16_t* Kg = qkv + 4 * TENS + (size_t)(b * 8 + head) * 4096 * 64;
  const bf16_t* Vg = qkv + 5 * TENS + (size_t)(b * 8 + head) * 64 * 4096;
  const int q0 = qb * 128 + w * 32;
  const int qpos = q0 + r;
  bf16x8 qf[4];
#pragma unroll
  for (int ks = 0; ks < 4; ++ks) qf[ks] = *(const bf16x8*)(Qg + (size_t)qpos * 64 + ks * 16 + h * 8);
  f32x16 o[2];
#pragma unroll
  for (int mb = 0; mb < 2; ++mb)
#pragma unroll
    for (int e = 0; e < 16; ++e) o[mb][e] = 0.f;
  float carry = 1.f;
  const int ntiles = 2 * qb + 2;
  const int first_tile = 2 * qb + (w >> 1);
  const int prow = pi_row(r);

  SB_ISSUE(ntiles - 1, 0)
  asm volatile("s_waitcnt vmcnt(0)" ::: "memory");
  __syncthreads();

  for (int it = 0; it < ntiles; ++it) {
    const int kt = ntiles - 1 - it;
    const int buf = it & 1;
    if (kt > 0) SB_ISSUE(kt - 1, buf ^ 1)
    if (kt <= first_tile && !__all(carry < 0x1p-136f)) {
      const bf16_t* sK = sbase + buf * BUF_E;
      const bf16_t* sV = sK + KT_E;
      if (kt == first_tile) sb_tile<true>(sK, sV, qf, o, carry, prow, r, h, kt * 64, qpos);
      else sb_tile<false>(sK, sV, qf, o, carry, prow, r, h, kt * 64, qpos);
    }
    asm volatile("s_waitcnt vmcnt(0)" ::: "memory");
    const int wdone = __all(carry < 0x1p-136f);
    if (lane == 0) sflag[buf * 4 + w] = wdone;
    __syncthreads();
    if (sflag[buf * 4] & sflag[buf * 4 + 1] & sflag[buf * 4 + 2] & sflag[buf * 4 + 3]) break;
  }
#undef SB_ISSUE
  __syncthreads();
  const int tok = b * 4096 + qpos;
  bf16_t* gp = gbase + (size_t)tok * 1536 + 512 + head * 64;
#pragma unroll
  for (int mb = 0; mb < 2; ++mb)
#pragma unroll
    for (int g = 0; g < 4; ++g) {
      const int dv = mb * 32 + 8 * g + 4 * h;
      bf16_t* a = gp + dv;
      const u32x2 gt = *(const u32x2*)a;
      const float v0 = o[mb][4 * g] * bflo(gt[0]);
      const float v1 = o[mb][4 * g + 1] * bfhi(gt[0]);
      const float v2 = o[mb][4 * g + 2] * bflo(gt[1]);
      const float v3 = o[mb][4 * g + 3] * bfhi(gt[1]);
      u32x2 st = {pk2(v0, v1), pk2(v2, v3)};
      *(u32x2*)a = st;
    }
}

DI bool decode_item(int xq, int q, const float* __restrict__ fb, int& type, int& bh, int& qb) {
  if (q < 128) { type = 0; bh = 2 * xq + (q >> 6); qb = 63 - (q & 63); return true; }
  if (q < 256) {
    const int j = q - 128, want = j >> 5;
    const int h0 = (4 * xq) & 7;
    int pick = 0;
#pragma unroll
    for (int k = 0; k < 4; ++k) {
      int rank = 0;
#pragma unroll
      for (int k2 = 0; k2 < 4; ++k2) rank += (fb[h0 + k2] > fb[h0 + k] || (fb[h0 + k2] == fb[h0 + k] && k2 < k)) ? 1 : 0;
      if (rank == want) pick = k;
    }
    type = 2; bh = 4 * xq + pick; qb = 31 - (j & 31);
    return true;
  }
  if (q < 384) { const int j = q - 256; type = 1; bh = 4 * xq + (j & 3); qb = 31 - (j >> 2); return true; }
  return false;
}

#define XB_TMO      128
#define XB_XCNT(j)  (256  + 64 * (j))
#define XB_XSUB(j)  (1280 + 64 * (j))
#define XB_XGEN(j)  (2304 + 64 * (j))
#define XB_TOP      3328
#define XB_TOPGEN   3392
#define XCD_BAR_WORDS 3456
#define XB_SPIN_CAP (1u << 22)
#define LAS __attribute__((address_space(3)))
DI unsigned xb_ld(unsigned* p) { return __hip_atomic_load(p, __ATOMIC_RELAXED, __HIP_MEMORY_SCOPE_AGENT); }
DI unsigned xb_add(unsigned* p, unsigned v) { return __hip_atomic_fetch_add(p, v, __ATOMIC_RELAXED, __HIP_MEMORY_SCOPE_AGENT); }
DI unsigned xb_xcc_id() { return (unsigned)__builtin_amdgcn_s_getreg((3 << 11) | 20) & 0xFu; }
#define XB_SPIN(cond, bar) do { unsigned _sp = 0; while (cond) { __builtin_amdgcn_s_sleep(1); \
    if ((++_sp & 255u) == 0u) { if (xb_ld(&(bar)[XB_TMO])) break; if (_sp > XB_SPIN_CAP) { atomicAdd(&(bar)[XB_TMO], 1u); break; } } } } while (0)
struct XcdBarrier { unsigned* bar; unsigned x; volatile LAS unsigned* st; };
DI XcdBarrier xcd_barrier_post(unsigned* bar, volatile LAS unsigned* st) {
  XcdBarrier b; b.bar = bar; b.x = xb_xcc_id(); b.st = st;
  if (tid_opaque() == 0) (void)xb_add(&bar[XB_XCNT(b.x)], 1u);
  return b;
}
DI void xcd_barrier_complete(unsigned* bar, unsigned x, unsigned& nloc, unsigned& nx) {
  const unsigned G = gridDim.x * gridDim.y * gridDim.z;
  unsigned sum, cnt, mine, sp = 0u;
  for (;;) {
    sum = 0u; cnt = 0u; mine = 0u;
#pragma unroll
    for (unsigned j = 0; j < 16; ++j) { const unsigned c = xb_ld(&bar[XB_XCNT(j)]); sum += c; cnt += (c > 0u) ? 1u : 0u; mine = (j == x) ? c : mine; }
    if (sum == G) break;
    __builtin_amdgcn_s_sleep(1);
    if ((++sp & 255u) == 0u) { if (xb_ld(&bar[XB_TMO])) break; if (sp > XB_SPIN_CAP) { atomicAdd(&bar[XB_TMO], 1u); break; } }
  }
  nloc = mine > 0u ? mine : 1u; nx = cnt > 0u ? cnt : 1u;
}
DI void xcd_barrier_impl(const XcdBarrier& b) {
  asm volatile("s_waitcnt vmcnt(0)" ::: "memory");
  __syncthreads();
  if (tid_opaque() == 0) {
    unsigned* bar = b.bar;
    __builtin_amdgcn_s_waitcnt(0);
    unsigned nloc = b.st[0], nx = b.st[1];
    if (nloc == 0u) { xcd_barrier_complete(bar, b.x, nloc, nx); b.st[0] = nloc; b.st[1] = nx; }
    const unsigned old = xb_add(&bar[XB_XSUB(b.x)], 1u);
    const unsigned gen = old / nloc;
    if (old + 1u == (gen + 1u) * nloc) {
      __builtin_amdgcn_fence(__ATOMIC_RELEASE, "agent");
      asm volatile("s_waitcnt vmcnt(0)" ::: "memory");
      const unsigned og = xb_add(&bar[XB_TOP], 1u);
      const unsigned tg = og / nx;
      if (og + 1u == (tg + 1u) * nx) xb_add(&bar[XB_TOPGEN], 1u);
      else XB_SPIN(xb_ld(&bar[XB_TOPGEN]) == tg, bar);
      __builtin_amdgcn_fence(__ATOMIC_ACQUIRE, "agent");
      xb_add(&bar[XB_XGEN(b.x)], 1u);
      asm volatile("s_waitcnt vmcnt(0)" ::: "memory");
    } else {
      XB_SPIN(xb_ld(&bar[XB_XGEN(b.x)]) == gen, bar);
      __builtin_amdgcn_fence(__ATOMIC_ACQUIRE, "agent");
      asm volatile("s_waitcnt vmcnt(0)" ::: "memory");
    }
  }
  __syncthreads();
}
DI void xcd_barrier(const Params& p, volatile LAS unsigned* st) {
  XcdBarrier b; b.bar = (unsigned*)(p.ws + OFF_BAR); b.x = xb_xcc_id(); b.st = st;
  xcd_barrier_impl(b);
}

DI void phase_setup(const Params& p, char* smem) {
  unsigned char* ws = p.ws;
  const int nb = gridDim.x, bid = bid_opaque(), t = tid_opaque();
  if (bid == 0 && t < 64) { ((unsigned*)(ws + OFF_CTR))[t] = 0u; ((float*)(ws + OFF_KMAX))[t] = 0.f; }
  for (int e = bid * 256 + t; e < 4096 * 8; e += nb * 256) {
    const int s = e >> 3, i = e & 7;
    const float inv = powf(500000.0f, -(float)(2 * i) / 16.0f);
    const float ang = (float)s * inv;
    float sn, cs;
    sincosf(ang, &sn, &cs);
    ((float*)(ws + OFF_ROPE))[e] = cs;
    ((float*)(ws + OFF_ROPE))[4096 * 8 + e] = sn;
  }
  for (int it = bid; it < 1536; it += nb) {
    const int nblk = it % 96, kblk = it / 96;
    transpose_tile(p.w_in, DIN, (bf16_t*)(ws + OFF_WINT), 1024, kblk * 64, nblk * 64, smem);
  }
  stage_wf(p.w_in, smem);
  const int lane = t & 63, w = t >> 6;
#pragma unroll 1
  for (int row = bid * 4 + w; row < T; row += nb * 4) {
    f32x4 xv[4];
#pragma unroll
    for (int pp = 0; pp < 4; ++pp) xv[pp] = __builtin_nontemporal_load((const f32x4*)(p.x + (size_t)row * 1024 + 256 * pp + 4 * lane));
    prenorm_row(xv, p.gpre, (const float*)smem, p.fbias, (bf16_t*)(ws + OFF_H), (float*)(ws + OFF_LF), row, lane);
  }
  __syncthreads();
}

DI void phase_inproj(const Params& p, int layer, char* smem, int* s_item, const int var = 0) {
  unsigned char* ws = p.ws;
  for (int seq = blockIdx.x; seq < 32; seq += gridDim.x) cumsum_item((const float*)(ws + OFF_LF), (float*)(ws + OFF_CUM), seq, smem);
  if (var != 0) {
    for (int ti = blockIdx.x; ti < 64 * 48; ti += gridDim.x) {
      int mt, nt;
      tile_coords(ti, 8, mt, nt);
      inproj_tile(p, layer, mt, nt, smem, var);
    }
    return;
  }
  unsigned* ctr = (unsigned*)(ws + OFF_CTR) + 16 + layer * 8;
  const int home = (int)(xb_xcc_id() & 7u);
  const int t = tid_opaque();
  int cur = home, pend = 0;
  if (t == 0) pend = (int)atomicAdd(ctr + cur, 1u);
  for (;;) {
    if (t == 0) {
      int code = -1;
      for (;;) {
        if (pend < 384) { code = (cur << 16) | pend; break; }
        int best = 99, nxt = -1;
#pragma unroll
        for (int x = 0; x < 8; ++x) {
          const unsigned cx = xb_ld(ctr + x);
          const int d = (x - home) & 7;
          if (cx < 384u && d < best) { best = d; nxt = x; }
        }
        if (nxt < 0) break;
        cur = nxt;
        pend = (int)atomicAdd(ctr + cur, 1u);
      }
      *s_item = code;
    }
    __syncthreads();
    const int code = *s_item;
    __syncthreads();
    if (code < 0) break;
    if (t == 0) pend = (int)atomicAdd(ctr + cur, 1u);
    const int xq = code >> 16, q = code & 0xffff;
    const int ti = (5 - (q >> 6)) * 512 + (q & 63) * 8 + xq;
    int mt, nt;
    tile_coords(ti, 8, mt, nt);
    inproj_tile(p, layer, mt, nt, smem, 0);
  }
}

DI void phase_attn(const Params& p, int layer, char* smem, int* s_item, const int ctr_base = 0, const int type_mask = 7, bf16_t* gbase = nullptr, const int var = 0) {
  unsigned* ctr = (unsigned*)(p.ws + OFF_CTR) + ctr_base + layer * 8;
  if (gbase == nullptr) gbase = (bf16_t*)(p.ws + OFF_G);
  const int home = (int)(xb_xcc_id() & 7u);
  const int t = tid_opaque();
  int step = 0, pend = 0;
  if (t == 0) pend = (int)atomicAdd(ctr + (home & 7), 1u);
  for (;;) {
    if (t == 0) {
      int code = -1;
      while (step < 8) {
        if (pend < 384) { code = (((home + step) & 7) << 16) | pend; break; }
        ++step;
        if (step < 8) pend = (int)atomicAdd(ctr + ((home + step) & 7), 1u);
      }
      *s_item = code;
    }
    __syncthreads();
    const int code = *s_item;
    __syncthreads();
    if (code < 0) break;
    if (t == 0) pend = (int)atomicAdd(ctr + ((home + step) & 7), 1u);
    int type, bh, qb;
    if (!decode_item(code >> 16, code & 0xffff, p.fbias + layer * 8, type, bh, qb)) break;
    if (!((type_mask >> type) & 1)) continue;
    if (type == 0) attn_softmax_item<true>(p, layer, bh >> 2, bh & 3, qb, smem, gbase, var);
    else if (type == 1) attn_sb_item(p, bh >> 3, bh & 7, qb, smem, gbase);
    else attn_softmax_item<false>(p, layer, bh >> 3, bh & 7, qb, smem, gbase, var);
  }
  if (layer == 0 && ctr_base == 0) {
    unsigned* tctr = (unsigned*)(p.ws + OFF_CTR) + 60;
    for (;;) {
      if (t == 0) *s_item = (int)atomicAdd(tctr, 1u);
      __syncthreads();
      const int it = *s_item;
      __syncthreads();
      if (it >= 768 + 1536) break;
      if (it < 768) {
        const int lay = it / 384, jj = it % 384;
        const int nblk = jj % 16, kblk = jj / 16;
        transpose_tile(p.w_out + (size_t)lay * 1536 * 1024, 1024, (bf16_t*)(p.ws + OFF_WOUTT) + (size_t)lay * 1024 * 1536, 1536, kblk * 64, nblk * 64, smem);
      } else {
        const int j = it - 768;
        const int nblk = j % 96, kblk = j / 96;
        transpose_tile(p.w_in + (size_t)1024 * DIN, DIN, (bf16_t*)(p.ws + OFF_WINT), 1024, kblk * 64, nblk * 64, smem);
      }
    }
  }
}

DI void phase_outproj(const Params& p, int layer, char* smem) {
  for (int ti = blockIdx.x; ti < 64 * 8; ti += gridDim.x) {
    int mt, nt;
    tile_coords(ti, 8, mt, nt);
    outproj_tile(p, layer, mt, nt, smem);
  }
}

DI void phase_postnorm(const Params& p, int layer, char* smem) {
  unsigned char* ws = p.ws;
  const int t = tid_opaque(), lane = t & 63, w = t >> 6;
  if (layer == 0) stage_wf(p.w_in + (size_t)1024 * DIN, smem);
  const bf16_t* y = (const bf16_t*)(ws + OFF_QKV);
  const float* xin = (layer == 0) ? p.x : p.out;
  const float* gpost = p.gpost + layer * 1024;
#pragma unroll 1
  for (int row = blockIdx.x * 4 + w; row < T; row += gridDim.x * 4) {
    f32x4 yv[4], xv[4];
    float ss = 0.f;
#pragma unroll
    for (int pp = 0; pp < 4; ++pp) {
      const u32x2 yb = __builtin_nontemporal_load((const u32x2*)(y + (size_t)row * 1024 + 256 * pp + 4 * lane));
      yv[pp][0] = bflo(yb[0]); yv[pp][1] = bfhi(yb[0]); yv[pp][2] = bflo(yb[1]); yv[pp][3] = bfhi(yb[1]);
      xv[pp] = __builtin_nontemporal_load((const f32x4*)(xin + (size_t)row * 1024 + 256 * pp + 4 * lane));
#pragma unroll
      for (int i = 0; i < 4; ++i) ss += yv[pp][i] * yv[pp][i];
    }
    ss = wave_sum(ss);
    const float rinv = rsqrtf(ss * (1.f / 1024.f) + NORM_EPS);
#pragma unroll
    for (int pp = 0; pp < 4; ++pp) {
      const f32x4 g = *(const f32x4*)(gpost + 256 * pp + 4 * lane);
#pragma unroll
      for (int i = 0; i < 4; ++i) xv[pp][i] += yv[pp][i] * rinv * g[i];
      *(f32x4*)(p.out + (size_t)row * 1024 + 256 * pp + 4 * lane) = xv[pp];
    }
    if (layer == 0)
      prenorm_row(xv, p.gpre + 1024, (const float*)smem, p.fbias + 8, (bf16_t*)(ws + OFF_H), (float*)(ws + OFF_LF), row, lane);
  }
  __syncthreads();
}

__global__ void __launch_bounds__(256, 2) fwd_kernel(Params p) {
  __shared__ __attribute__((aligned(1024))) char smem[SMEM_BYTES];
  __shared__ uint4 xb_words;
  __shared__ int s_item;
  if (tid_opaque() == 0) xb_words = make_uint4(0u, 0u, 0u, 0u);
  __syncthreads();
  (void)xcd_barrier_post((unsigned*)(p.ws + OFF_BAR), (volatile LAS unsigned*)&xb_words);
  if (p.ws == nullptr) cg::this_grid().sync();
  for (int rep = 0; rep < (DUP_PHASE == 0 ? 2 : 1); ++rep) { phase_setup(p, smem); xcd_barrier(p, (volatile LAS unsigned*)&xb_words); }
#pragma unroll 1
  for (int layer = 0; layer < 2; ++layer) {
    for (int rep = 0; rep < (DUP_PHASE == 1 ? 2 - layer : 1); ++rep) { phase_inproj(p, layer, smem, &s_item, rep ? EXP_VAR : 0); xcd_barrier(p, (volatile LAS unsigned*)&xb_words); }
    phase_attn(p, layer, smem, &s_item);
    xcd_barrier(p, (volatile LAS unsigned*)&xb_words);
    if (DUP_PHASE == 2 && layer == 0) { phase_attn(p, layer, smem, &s_item, 32, EXP_VAR & 7, (bf16_t*)p.out, EXP_VAR >> 3); xcd_barrier(p, (volatile LAS unsigned*)&xb_words); }
    for (int rep = 0; rep < (DUP_PHASE == 3 ? 2 - layer : 1); ++rep) { phase_outproj(p, layer, smem); xcd_barrier(p, (volatile LAS unsigned*)&xb_words); }
    for (int rep = 0; rep < (DUP_PHASE == 4 ? 2 - layer : 1); ++rep) { phase_postnorm(p, layer, smem); if (layer == 0) xcd_barrier(p, (volatile LAS unsigned*)&xb_words); }
  }
}

extern "C" void kernel_launch(void* const* d_in, const int* in_sizes, int n_in, void* d_out, int out_size, void* d_ws, size_t ws_size,
                              hipStream_t stream) {
  static int grid_blocks = 0;
  if (!grid_blocks) {
    int dev = 0, cus = 0, per_cu = 0;
    (void)hipGetDevice(&dev);
    (void)hipDeviceGetAttribute(&cus, hipDeviceAttributeMultiprocessorCount, dev);
    (void)hipOccupancyMaxActiveBlocksPerMultiprocessor(&per_cu, fwd_kernel, 256, 0);
    if (per_cu > 2) per_cu = 2;
    if (per_cu < 1) per_cu = 1;
    grid_blocks = cus * per_cu;
    if (ws_size < WS_NEED) fprintf(stderr, "workspace too small: %zu < %zu\n", ws_size, WS_NEED);
  }
  Params p{};
  p.x = (const float*)d_in[0]; p.w_in = (const float*)d_in[1]; p.fbias = (const float*)d_in[2]; p.dlam = (const float*)d_in[3];
  p.subln = (const float*)d_in[4]; p.w_out = (const float*)d_in[5]; p.gpre = (const float*)d_in[6]; p.gpost = (const float*)d_in[7];
  p.out = (float*)d_out; p.ws = (unsigned char*)d_ws;
  (void)hipMemsetAsync((unsigned char*)d_ws + OFF_BAR, 0, XCD_BAR_WORDS * 4, stream);
  void* args[] = {&p};
  hipError_t e = hipLaunchCooperativeKernel((void*)fwd_kernel, dim3(grid_blocks), dim3(256), args, 0, stream);
  if (e != hipSuccess) fprintf(stderr, "cooperative launch failed: %s (grid %d)\n", hipGetErrorString(e), grid_blocks);
}
```

```cpp
#include <hip/hip_runtime.h>
#include <hip/hip_cooperative_groups.h>
#include <cstdio>
namespace cg = cooperative_groups;

#ifndef EXP_VAR
#define EXP_VAR 0
#endif
#ifndef DUP_PHASE
#define DUP_PHASE -1
#endif

typedef unsigned short bf16_t;
typedef short bf16x8 __attribute__((ext_vector_type(8)));
typedef float f32x16 __attribute__((ext_vector_type(16)));
typedef float f32x4 __attribute__((ext_vector_type(4)));
typedef float f32x2 __attribute__((ext_vector_type(2)));
typedef __bf16 bf16x2n __attribute__((ext_vector_type(2)));
typedef unsigned u32x2 __attribute__((ext_vector_type(2)));
typedef unsigned u32x4 __attribute__((ext_vector_type(4)));

#define DI __device__ __forceinline__
#define MFMA32(a, b, c) __builtin_amdgcn_mfma_f32_32x32x16_bf16((a), (b), (c), 0, 0, 0)

constexpr int T = 16384, S = 4096, D = 1024, DIN = 6152, DMIX = 1536;
constexpr int LROW = 72;
constexpr float LOG2E = 1.4426950408889634f;
constexpr float NORM_EPS = 1e-6f;
constexpr int SMEM_BYTES = 73728;

constexpr size_t OFF_WINT = 0;
constexpr size_t OFF_WOUTT = OFF_WINT + (size_t)6144 * 1024 * 2;
constexpr size_t OFF_H = OFF_WOUTT + (size_t)2 * 1024 * 1536 * 2;
constexpr size_t OFF_QKV = OFF_H + (size_t)T * 1024 * 2;
constexpr size_t TENS = (size_t)T * 512;
constexpr size_t OFF_G = OFF_QKV + 9 * TENS * 2;
constexpr size_t OFF_LF = OFF_G + (size_t)T * 1536 * 2;
constexpr size_t OFF_CUM = OFF_LF + (size_t)32 * 4096 * 4;
constexpr size_t OFF_ROPE = OFF_CUM + (size_t)32 * 4096 * 4;
constexpr size_t OFF_CTR = OFF_ROPE + (size_t)2 * 4096 * 8 * 4;
constexpr size_t OFF_KMAX = OFF_CTR + 1024;
constexpr size_t OFF_BAR = OFF_CTR + 4096;
constexpr size_t WS_NEED = OFF_BAR + 16384;

struct Params {
  const float* x; const float* w_in; const float* fbias; const float* dlam; const float* subln;
  const float* w_out; const float* gpre; const float* gpost; float* out; unsigned char* ws;
};

DI int tid_opaque() { int t = threadIdx.x; asm volatile("" : "+v"(t)); return t; }
DI int bid_opaque() { int b = blockIdx.x; asm volatile("" : "+s"(b)); return b; }
DI unsigned pk2(float a, float b) { f32x2 v = {a, b}; bf16x2n r = __builtin_convertvector(v, bf16x2n); return __builtin_bit_cast(unsigned, r); }
DI float bflo(unsigned u) { return __uint_as_float(u << 16); }
DI float bfhi(unsigned u) { return __uint_as_float(u & 0xffff0000u); }
DI float wave_sum(float v) {
#pragma unroll
  for (int o = 32; o; o >>= 1) v += __shfl_xor(v, o);
  return v;
}
DI float xhalf(float v) { return __shfl_xor(v, 32); }
DI float xmax(float v) {
  auto r = __builtin_amdgcn_permlane32_swap(__float_as_uint(v), __float_as_uint(v), false, false);
  return fmaxf(__uint_as_float(r[0]), __uint_as_float(r[1]));
}
DI float xsum(float v) {
  auto r = __builtin_amdgcn_permlane32_swap(__float_as_uint(v), __float_as_uint(v), false, false);
  return __uint_as_float(r[0]) + __uint_as_float(r[1]);
}
DI void xboth(float v, float& lo, float& hi) {
  auto r = __builtin_amdgcn_permlane32_swap(__float_as_uint(v), __float_as_uint(v), false, false);
  lo = __uint_as_float(r[0]); hi = __uint_as_float(r[1]);
}
DI u32x4 swap_pair(u32x2 pe, u32x2 po) {
  auto r0 = __builtin_amdgcn_permlane32_swap(pe[0], po[0], false, false);
  auto r1 = __builtin_amdgcn_permlane32_swap(pe[1], po[1], false, false);
  u32x4 o = {r0[0], r1[0], r0[1], r1[1]};
  return o;
}
DI bf16x8 pack8(float a0, float a1, float a2, float a3, float a4, float a5, float a6, float a7) {
  u32x4 u = {pk2(a0, a1), pk2(a2, a3), pk2(a4, a5), pk2(a6, a7)};
  return __builtin_bit_cast(bf16x8, u);
}
DI float log_sigmoid_f(float v) { return fminf(v, 0.f) - __logf(1.f + __expf(-fabsf(v))); }

DI void transpose_tile(const float* __restrict__ src, int ldn, bf16_t* __restrict__ dst, int K, int k0, int n0, char* smem) {
  float* tile = (float*)smem;
  const int t = tid_opaque();
#pragma unroll
  for (int p = 0; p < 16; ++p) {
    const int k = p * 4 + (t >> 6), n = t & 63;
    tile[k * 65 + n] = src[(size_t)(k0 + k) * ldn + n0 + n];
  }
  __syncthreads();
#pragma unroll
  for (int p = 0; p < 8; ++p) {
    const int n = p * 8 + (t >> 5), k = (t & 31) * 2;
    *(unsigned*)(dst + (size_t)(n0 + n) * K + k0 + k) = pk2(tile[k * 65 + n], tile[(k + 1) * 65 + n]);
  }
  __syncthreads();
}

DI void stage_wf(const float* __restrict__ w_in_l, char* smem) {
  float* wf = (float*)smem;
  const int t0 = tid_opaque();
  for (int e = t0; e < 2048; e += 256) {
    const int k = e >> 1, half = e & 1;
    const f32x4 v = *(const f32x4*)(w_in_l + (size_t)k * DIN + 6144 + half * 4);
#pragma unroll
    for (int i = 0; i < 4; ++i) wf[(half * 4 + i) * 1024 + k] = v[i];
  }
  __syncthreads();
}

DI void prenorm_row(const f32x4 (&xv)[4], const float* __restrict__ gpre, const float* wf, const float* __restrict__ fbias,
                    bf16_t* __restrict__ hbuf, float* __restrict__ lf, int tok, int lane) {
  float ss = 0.f;
#pragma unroll
  for (int p = 0; p < 4; ++p)
#pragma unroll
    for (int i = 0; i < 4; ++i) ss += xv[p][i] * xv[p][i];
  ss = wave_sum(ss);
  const float rinv = rsqrtf(ss * (1.f / 1024.f) + NORM_EPS);
  float ff[8];
#pragma unroll
  for (int hh = 0; hh < 8; ++hh) ff[hh] = 0.f;
#pragma unroll
  for (int p = 0; p < 4; ++p) {
    const f32x4 g = *(const f32x4*)(gpre + 256 * p + 4 * lane);
    f32x4 hv;
#pragma unroll
    for (int i = 0; i < 4; ++i) hv[i] = xv[p][i] * rinv * g[i];
    u32x2 st = {pk2(hv[0], hv[1]), pk2(hv[2], hv[3])};
    *(u32x2*)(hbuf + (size_t)tok * 1024 + 256 * p + 4 * lane) = st;
#pragma unroll
    for (int hh = 0; hh < 8; ++hh) {
      const f32x4 w = *(const f32x4*)(wf + hh * 1024 + 256 * p + 4 * lane);
      ff[hh] += hv[0] * w[0] + hv[1] * w[1] + hv[2] * w[2] + hv[3] * w[3];
    }
    __builtin_amdgcn_sched_barrier(0);
  }
  float mine = 0.f;
#pragma unroll
  for (int hh = 0; hh < 8; ++hh) {
    const float s = wave_sum(ff[hh]);
    if (lane == hh) mine = s;
  }
  if (lane < 8) lf[((size_t)(tok >> 12) * 8 + lane) * 4096 + (tok & 4095)] = log_sigmoid_f(mine + fbias[lane]);
}

DI void cumsum_item(const float* __restrict__ lf, float* __restrict__ cum, int seq, char* smem) {
  float* sm = (float*)smem;
  const int t = tid_opaque(), lane = t & 63, w = t >> 6;
  float v[16];
#pragma unroll
  for (int p = 0; p < 4; ++p) {
    const f32x4 a = *(const f32x4*)(lf + (size_t)seq * 4096 + 16 * t + 4 * p);
#pragma unroll
    for (int i = 0; i < 4; ++i) v[4 * p + i] = a[i];
  }
#pragma unroll
  for (int i = 1; i < 16; ++i) v[i] += v[i - 1];
  float tot = v[15];
  float inc = tot;
#pragma unroll
  for (int o = 1; o < 64; o <<= 1) { const float n = __shfl_up(inc, o); if (lane >= o) inc += n; }
  if (lane == 63) sm[w] = inc;
  __syncthreads();
  float base = inc - tot;
  for (int i = 0; i < w; ++i) base += sm[i];
#pragma unroll
  for (int p = 0; p < 4; ++p) {
    f32x4 a;
#pragma unroll
    for (int i = 0; i < 4; ++i) a[i] = (v[4 * p + i] + base) * LOG2E;
    *(f32x4*)(cum + (size_t)seq * 4096 + 16 * t + 4 * p) = a;
  }
  __syncthreads();
}

constexpr int GA_BYTES = 256 * 64, GB_BYTES = 128 * 64, GSTAGE = GA_BYTES + GB_BYTES;
typedef __attribute__((address_space(3))) void* lds_vp;
typedef const __attribute__((address_space(1))) void* glb_vp;
DI void glds16(const char* g, char* lds_wave_base) {
  __builtin_amdgcn_global_load_lds((glb_vp)(unsigned long long)g, (lds_vp)(unsigned)(unsigned long long)lds_wave_base, 16, 0, 0);
}
template <bool TR>
DI void gemm_mainloop(const int t, const bf16_t* __restrict__ A, int lda, const bf16_t* __restrict__ B, int ldb, int K, char* smem, f32x16 (&acc)[4][2], const int var = 0) {
  const int lane = t & 63, w = t >> 6, wm = w >> 1, wn = w & 1, r = lane & 31, h = lane >> 5;
  const int wu = __builtin_amdgcn_readfirstlane(w);
  const int srow = lane >> 2, schunk = (lane & 3) ^ ((lane >> 4) & 3);
  unsigned aoff[4], boff[2];
#pragma unroll
  for (int p = 0; p < 4; ++p) aoff[p] = (unsigned)((((p * 4 + wu) * 16 + srow) * lda + schunk * 8) * 2);
#pragma unroll
  for (int p = 0; p < 2; ++p) boff[p] = (unsigned)((((p * 4 + wu) * 16 + srow) * ldb + schunk * 8) * 2);
  const char* Ab = (const char*)A;
  const char* Bb = (const char*)B;
  char* dA = smem + wu * 1024;
  char* dB = smem + GA_BYTES + wu * 1024;
#pragma unroll
  for (int p = 0; p < 4; ++p) glds16(Ab + aoff[p], dA + p * 4096);
#pragma unroll
  for (int p = 0; p < 2; ++p) glds16(Bb + boff[p], dB + p * 4096);
  const int fsw = (h ^ ((r >> 2) & 3)) * 16;
  const int fa0 = (wm * 128 + r) * 64 + fsw, fa1 = fa0 ^ 32;
  const int fb0 = GA_BYTES + (wn * 64 + r) * 64 + fsw, fb1 = fb0 ^ 32;
  asm volatile("s_waitcnt vmcnt(0)" ::: "memory");
  __syncthreads();
  const int nk = K >> 5;
  const bool skip = (var & 2) != 0;
  for (int kt = 0; kt < nk; ++kt) {
    const int buf = kt & 1;
    if (kt + 1 < nk && !skip) {
      Ab += 64; Bb += 64;
      char* nA = dA + (buf ^ 1) * GSTAGE;
      char* nB = dB + (buf ^ 1) * GSTAGE;
#pragma unroll
      for (int p = 0; p < 4; ++p) glds16(Ab + aoff[p], nA + p * 4096);
#pragma unroll
      for (int p = 0; p < 2; ++p) glds16(Bb + boff[p], nB + p * 4096);
    }
    const char* sb = smem + buf * GSTAGE;
    bf16x8 a0[4], b0[2], a1[4], b1[2];
#pragma unroll
    for (int i = 0; i < 4; ++i) a0[i] = *(const bf16x8*)(sb + fa0 + i * 2048);
#pragma unroll
    for (int j = 0; j < 2; ++j) b0[j] = *(const bf16x8*)(sb + fb0 + j * 2048);
    __builtin_amdgcn_sched_barrier(0);
#pragma unroll
    for (int i = 0; i < 4; ++i) a1[i] = *(const bf16x8*)(sb + fa1 + i * 2048);
#pragma unroll
    for (int j = 0; j < 2; ++j) b1[j] = *(const bf16x8*)(sb + fb1 + j * 2048);
#pragma unroll
    for (int i = 0; i < 4; ++i)
#pragma unroll
      for (int j = 0; j < 2; ++j) {
        if (!TR) acc[i][j] = MFMA32(a0[i], b0[j], acc[i][j]);
        else acc[i][j] = MFMA32(b0[j], a0[i], acc[i][j]);
      }
#pragma unroll
    for (int i = 0; i < 4; ++i)
#pragma unroll
      for (int j = 0; j < 2; ++j) {
        if (!TR) acc[i][j] = MFMA32(a1[i], b1[j], acc[i][j]);
        else acc[i][j] = MFMA32(b1[j], a1[i], acc[i][j]);
      }
#pragma unroll
    for (int g = 0; g < 6; ++g) {
      __builtin_amdgcn_sched_group_barrier(0x008, 1, 0);
      __builtin_amdgcn_sched_group_barrier(0x100, 1, 0);
    }
    __builtin_amdgcn_sched_group_barrier(0x008, 10, 0);
    __builtin_amdgcn_sched_barrier(0);
    asm volatile("s_waitcnt vmcnt(0)" ::: "memory");
    __syncthreads();
  }
}

DI void zero_acc(f32x16 (&acc)[4][2]) {
#pragma unroll
  for (int i = 0; i < 4; ++i)
#pragma unroll
    for (int j = 0; j < 2; ++j)
#pragma unroll
      for (int e = 0; e < 16; ++e) acc[i][j][e] = 0.f;
}

DI void tile_coords(int tidx, int n_super_m, int& mt, int& nt) {
  const int j = tidx >> 9, bb = tidx & 511, xcd = bb & 7, local = bb >> 3;
  const int st = j * 8 + xcd;
  const int sm = st % n_super_m, sn = st / n_super_m;
  mt = sm * 8 + (local & 7);
  nt = sn * 8 + (local >> 3);
}

DI void inproj_tile(const Params& p, int layer, int mt, int nt, char* smem, const int var = 0) {
  unsigned char* ws = p.ws;
  const bf16_t* hb = (const bf16_t*)(ws + OFF_H) + (size_t)mt * 256 * 1024;
  const bf16_t* wb = (const bf16_t*)(ws + OFF_WINT) + (size_t)nt * 128 * 1024;
  const int t = tid_opaque(), lane = t & 63, w = t >> 6, wm = w >> 1, wn = w & 1, r = lane & 31, h = lane >> 5;
  const int split = nt >> 2, kind = split & 3, grp = split >> 2;
  f32x16 acc[4][2];
  zero_acc(acc);
  if (kind == 2) {
    gemm_mainloop<false>(t, hb, 1024, wb, 1024, 1024, smem, acc, var);
    if ((var & 1) && acc[0][0][0] != 12345.678f) return;
    bf16_t* tens = (bf16_t*)(ws + OFF_QKV) + (size_t)(grp * 3 + 2) * TENS;
    const int b = (mt * 256) >> 12, sbase = (mt * 256) & 4095;
#pragma unroll
    for (int j = 0; j < 2; ++j) {
      bf16_t* hp;
      int dv, DV;
      if (grp == 0) { hp = tens + (size_t)(b * 4 + (nt & 3)) * 4096 * 128; dv = wn * 64 + j * 32 + r; DV = 128; }
      else { hp = tens + (size_t)(b * 8 + (nt & 3) * 2 + wn) * 4096 * 64; dv = j * 32 + r; DV = 64; }
#pragma unroll
      for (int i = 0; i < 4; ++i)
#pragma unroll
        for (int g = 0; g < 4; g += 2) {
          const int s0 = sbase + wm * 128 + i * 32 + 8 * (g + h);
          u32x2 pe = {pk2(acc[i][j][4 * g], acc[i][j][4 * g + 1]), pk2(acc[i][j][4 * g + 2], acc[i][j][4 * g + 3])};
          u32x2 po = {pk2(acc[i][j][4 * g + 4], acc[i][j][4 * g + 5]), pk2(acc[i][j][4 * g + 6], acc[i][j][4 * g + 7])};
          *(u32x4*)(hp + ((size_t)((s0 >> 6) * DV + dv)) * 64 + (s0 & 63)) = swap_pair(pe, po);
        }
    }
  } else {
    gemm_mainloop<true>(t, hb, 1024, wb, 1024, 1024, smem, acc, var);
    if ((var & 1) && acc[0][0][0] != 12345.678f) return;
#pragma unroll
    for (int i = 0; i < 4; ++i) {
      const int tok = mt * 256 + wm * 128 + i * 32 + r;
      const int b = tok >> 12, s = tok & 4095;
      if (kind == 3) {
        bf16_t* gp = (bf16_t*)(ws + OFF_G) + (size_t)tok * 1536 + grp * 512 + (nt & 3) * 128 + wn * 64 + 8 * h;
#pragma unroll
        for (int j = 0; j < 2; ++j)
#pragma unroll
          for (int g = 0; g < 4; g += 2) {
            float v[8];
#pragma unroll
            for (int e = 0; e < 8; ++e) { const float a = acc[i][j][4 * g + e]; v[e] = a * __builtin_amdgcn_rcpf(1.f + __expf(-a)); }
            u32x2 pe = {pk2(v[0], v[1]), pk2(v[2], v[3])};
            u32x2 po = {pk2(v[4], v[5]), pk2(v[6], v[7])};
            *(u32x4*)(gp + j * 32 + 8 * g) = swap_pair(pe, po);
          }
      } else {
        const int hh = (nt & 3) * 2 + wn;
        if (grp == 2 && kind == 1) {
          float ss = 0.f;
#pragma unroll
          for (int j = 0; j < 2; ++j)
#pragma unroll
            for (int e = 0; e < 16; ++e) ss += acc[i][j][e] * acc[i][j][e];
          ss = xsum(ss);
#pragma unroll
          for (int o2 = 16; o2; o2 >>= 1) ss = fmaxf(ss, __shfl_xor(ss, o2));
          if (lane == 0) atomicMax((unsigned*)(ws + OFF_KMAX) + layer * 32 + b * 8 + hh, __float_as_uint(ss));
        }
        bf16_t* qp = (bf16_t*)(ws + OFF_QKV) + (size_t)(grp * 3 + kind) * TENS + ((size_t)(b * 8 + hh) * 4096 + s) * 64 + 8 * h;
        const float sc = (kind == 0) ? (grp == 1 ? -0.125f * LOG2E : 0.125f * LOG2E) : 1.f;
        f32x16 a0 = acc[i][0];
        if (grp == 0) {
          const f32x4 cs = *(const f32x4*)((const float*)(ws + OFF_ROPE) + s * 8 + 4 * h);
          const f32x4 sn = *(const f32x4*)((const float*)(ws + OFF_ROPE) + 4096 * 8 + s * 8 + 4 * h);
#pragma unroll
          for (int e = 0; e < 4; ++e) {
            const float r1 = a0[e], r2 = a0[4 + e];
            a0[e] = r1 * cs[e] - r2 * sn[e];
            a0[4 + e] = r2 * cs[e] + r1 * sn[e];
          }
        }
#pragma unroll
        for (int j = 0; j < 2; ++j)
#pragma unroll
          for (int g = 0; g < 4; g += 2) {
            float v[8];
#pragma unroll
            for (int e = 0; e < 8; ++e) v[e] = (j == 0 ? a0[4 * g + e] : acc[i][1][4 * g + e]) * sc;
            u32x2 pe = {pk2(v[0], v[1]), pk2(v[2], v[3])};
            u32x2 po = {pk2(v[4], v[5]), pk2(v[6], v[7])};
            *(u32x4*)(qp + j * 32 + 8 * g) = swap_pair(pe, po);
          }
      }
    }
  }
}

DI void outproj_tile(const Params& p, int layer, int mt, int nt, char* smem) {
  unsigned char* ws = p.ws;
  const bf16_t* ab = (const bf16_t*)(ws + OFF_G) + (size_t)mt * 256 * 1536;
  const bf16_t* wb = (const bf16_t*)(ws + OFF_WOUTT) + (size_t)layer * 1024 * 1536 + (size_t)nt * 128 * 1536;
  const int t = tid_opaque(), lane = t & 63, w = t >> 6, wm = w >> 1, wn = w & 1, r = lane & 31, h = lane >> 5;
  f32x16 acc[4][2];
  zero_acc(acc);
  gemm_mainloop<true>(t, ab, 1536, wb, 1536, 1536, smem, acc);
  bf16_t* y = (bf16_t*)(ws + OFF_QKV);
#pragma unroll
  for (int i = 0; i < 4; ++i) {
    const int tok = mt * 256 + wm * 128 + i * 32 + r;
    bf16_t* yp = y + (size_t)tok * 1024 + nt * 128 + wn * 64 + 8 * h;
#pragma unroll
    for (int j = 0; j < 2; ++j)
#pragma unroll
      for (int g = 0; g < 4; g += 2) {
        u32x2 pe = {pk2(acc[i][j][4 * g], acc[i][j][4 * g + 1]), pk2(acc[i][j][4 * g + 2], acc[i][j][4 * g + 3])};
        u32x2 po = {pk2(acc[i][j][4 * g + 4], acc[i][j][4 * g + 5]), pk2(acc[i][j][4 * g + 6], acc[i][j][4 * g + 7])};
        *(u32x4*)(yp + j * 32 + 8 * g) = swap_pair(pe, po);
      }
  }
}

DI int pi_row(int r) { return (r & 0x13) | ((r & 4) << 1) | ((r & 8) >> 1); }

template <int NR>
DI void tile_gload(const int t, const bf16_t* __restrict__ g, size_t gstride, u32x4* regs) {
  const int lrow = t >> 3, lch = t & 7;
#pragma unroll
  for (int p = 0; p < NR / 32; ++p) regs[p] = *(const u32x4*)(g + (size_t)(lrow + 32 * p) * gstride + lch * 8);
}
template <int NR>
DI void tile_swrite(const int t, bf16_t* s, const u32x4* regs) {
  const int lrow = t >> 3, lch = t & 7;
#pragma unroll
  for (int p = 0; p < NR / 32; ++p) *(u32x4*)(s + (lrow + 32 * p) * LROW + lch * 8) = regs[p];
}

DI float fmax2(float a, float b) { return __builtin_elementwise_maximum(a, b); }
template <int DVB, bool BIAS, bool MASK>
DI void softmax_tile(const bf16_t* sK, const bf16_t* sV, const float* cb, const bf16x8 (&qf)[4], f32x16 (&o)[DVB], float& m, float& l,
                     int prow, int r, int h, int kbase, int qpos) {
  bf16x8 kf[2][4];
#pragma unroll
  for (int sub = 0; sub < 2; ++sub)
#pragma unroll
    for (int ks = 0; ks < 4; ++ks) kf[sub][ks] = *(const bf16x8*)((const char*)sK + (sub * 32 + prow) * 128 + (((2 * ks + h) ^ ((prow >> 1) & 7)) << 4));
  __builtin_amdgcn_sched_barrier(0);
  f32x16 sc[2];
#pragma unroll
  for (int sub = 0; sub < 2; ++sub) {
    f32x16 z;
#pragma unroll
    for (int e = 0; e < 16; ++e) z[e] = 0.f;
    sc[sub] = MFMA32(kf[sub][0], qf[0], z);
#pragma unroll
    for (int ks = 1; ks < 4; ++ks) sc[sub] = MFMA32(kf[sub][ks], qf[ks], sc[sub]);
  }
  bf16x8 vf[2][4];
#pragma unroll
  for (int mb = 0; mb < 2; ++mb)
#pragma unroll
    for (int f = 0; f < 4; ++f) vf[mb][f] = *(const bf16x8*)((const char*)sV + (mb * 32 + r) * 128 + (((2 * f + h) ^ ((r >> 1) & 7)) << 4));
  if (BIAS) {
#pragma unroll
    for (int sub = 0; sub < 2; ++sub)
#pragma unroll
      for (int s2 = 0; s2 < 2; ++s2) {
        const f32x4 c0 = *(const f32x4*)(cb + sub * 32 + s2 * 16 + 8 * h);
        const f32x4 c1 = *(const f32x4*)(cb + sub * 32 + s2 * 16 + 8 * h + 4);
#pragma unroll
        for (int e = 0; e < 4; ++e) {
          sc[sub][8 * s2 + e] -= c0[e];
          sc[sub][8 * s2 + 4 + e] -= c1[e];
        }
      }
  }
  if (MASK) {
#pragma unroll
    for (int sub = 0; sub < 2; ++sub)
#pragma unroll
      for (int e = 0; e < 16; ++e) {
        const int key = kbase + sub * 32 + (e >> 3) * 16 + 8 * h + (e & 7);
        if (key > qpos) sc[sub][e] = -INFINITY;
      }
  }
  float mx = fmax2(sc[0][0], sc[1][0]);
#pragma unroll
  for (int e = 1; e < 16; ++e) mx = fmax2(fmax2(mx, sc[0][e]), sc[1][e]);
  mx = xmax(mx);
  if (__any(mx > m + 8.f)) {
    const float mn = fmaxf(m, mx);
    const float alpha = __builtin_amdgcn_exp2f(m - mn);
    m = mn;
    l *= alpha;
#pragma unroll
    for (int mb = 0; mb < DVB; ++mb)
#pragma unroll
      for (int e = 0; e < 16; ++e) o[mb][e] *= alpha;
  }
  float ls = 0.f;
  bf16x8 pf[4];
#pragma unroll
  for (int sub = 0; sub < 2; ++sub) {
#pragma unroll
    for (int e = 0; e < 16; ++e) { sc[sub][e] = __builtin_amdgcn_exp2f(sc[sub][e] - m); ls += sc[sub][e]; }
    pf[sub * 2 + 0] = pack8(sc[sub][0], sc[sub][1], sc[sub][2], sc[sub][3], sc[sub][4], sc[sub][5], sc[sub][6], sc[sub][7]);
    pf[sub * 2 + 1] = pack8(sc[sub][8], sc[sub][9], sc[sub][10], sc[sub][11], sc[sub][12], sc[sub][13], sc[sub][14], sc[sub][15]);
  }
  l += ls;
#pragma unroll
  for (int mb = 0; mb < 2; ++mb)
#pragma unroll
    for (int f = 0; f < 4; ++f) o[mb] = MFMA32(vf[mb][f], pf[f], o[mb]);
  if (DVB > 2) {
#pragma unroll
    for (int mb = 0; mb < 2; ++mb)
#pragma unroll
      for (int f = 0; f < 4; ++f) vf[mb][f] = *(const bf16x8*)((const char*)sV + ((mb + 2) * 32 + r) * 128 + (((2 * f + h) ^ ((r >> 1) & 7)) << 4));
    __builtin_amdgcn_sched_barrier(0);
#pragma unroll
    for (int mb = 0; mb < 2; ++mb)
#pragma unroll
      for (int f = 0; f < 4; ++f) o[(DVB > 2) ? mb + 2 : mb] = MFMA32(vf[mb][f], pf[f], o[(DVB > 2) ? mb + 2 : mb]);
  }
}

template <bool DIFF>
DI void attn_softmax_item(const Params& p, int layer, int b, int head, int qb, char* smem, bf16_t* gbase, const int var = 0) {
  constexpr int NK = DIFF ? 2 : 1;
  constexpr int DVB = DIFF ? 4 : 2;
  constexpr int VROWS = DVB * 32;
  constexpr int KT_E = 64 * 64, VT_E = VROWS * 64, BUF_E = NK * KT_E + VT_E;
  unsigned char* ws = p.ws;
  bf16_t* sbase = (bf16_t*)smem;
  float* scum = (float*)(smem + 2 * BUF_E * 2);
  const int t = tid_opaque(), lane = t & 63, w = t >> 6, r = lane & 31, h = lane >> 5;
  const int wu = __builtin_amdgcn_readfirstlane(w);
  unsigned soff[4];
#pragma unroll
  for (int pp = 0; pp < 4; ++pp) soff[pp] = (unsigned)((8 * (pp * 4 + wu) + (lane >> 3)) * 128 + (((lane & 7) ^ (((wu & 1) << 2) + ((lane >> 4) & 3))) << 4));
#define ATT_ISSUE(KT, BUF)                                                                                                   \
  {                                                                                                                          \
    char* d_ = smem + (BUF) * (BUF_E * 2) + wu * 1024;                                                                       \
    _Pragma("unroll") for (int c = 0; c < NK; ++c)                                                                           \
      _Pragma("unroll") for (int pp = 0; pp < 2; ++pp)                                                                       \
        glds16((const char*)(Kg[c] + (size_t)(KT) * 64 * 64) + soff[pp], d_ + c * (KT_E * 2) + pp * 4096);                   \
    _Pragma("unroll") for (int pp = 0; pp < VROWS / 32; ++pp)                                                                \
      glds16((const char*)(Vg + (size_t)(KT) * VROWS * 64) + soff[pp], d_ + NK * (KT_E * 2) + pp * 4096);                    \
  }
  const int cw = DIFF ? (w >> 1) : 0;
  const bf16_t* qkv = (const bf16_t*)(ws + OFF_QKV);
  const bf16_t *Qg, *Kg[NK], *Vg;
  if (DIFF) {
#pragma unroll
    for (int c = 0; c < NK; ++c) Kg[c] = qkv + 1 * TENS + (size_t)(b * 8 + head * 2 + c) * 4096 * 64;
    Qg = qkv + 0 * TENS + (size_t)(b * 8 + head * 2 + cw) * 4096 * 64;
    Vg = qkv + 2 * TENS + (size_t)(b * 4 + head) * 128 * 4096;
  } else {
    Qg = qkv + 6 * TENS + (size_t)(b * 8 + head) * 4096 * 64;
    Kg[0] = qkv + 7 * TENS + (size_t)(b * 8 + head) * 4096 * 64;
    Vg = qkv + 8 * TENS + (size_t)(b * 8 + head) * 64 * 4096;
  }
  const float* cumg = (const float*)(ws + OFF_CUM) + (size_t)(b * 8 + head) * 4096;
  const int q0 = DIFF ? (qb * 64 + (w & 1) * 32) : (qb * 128 + w * 32);
  const int qpos = q0 + r;
  bf16x8 qf[4];
#pragma unroll
  for (int ks = 0; ks < 4; ++ks) qf[ks] = *(const bf16x8*)(Qg + (size_t)qpos * 64 + ks * 16 + h * 8);
  f32x16 o[DVB];
  float m = -INFINITY, l = 0.f;
#pragma unroll
  for (int mb = 0; mb < DVB; ++mb)
#pragma unroll
    for (int e = 0; e < 16; ++e) o[mb][e] = 0.f;
  const int ntiles = DIFF ? (qb + 1) : (2 * qb + 2);
  const int last_tile = DIFF ? qb : (2 * qb + (w >> 1));
  const int prow = pi_row(r);
  float qkb = 0.f;
  int* sflag = (int*)(smem + 2 * BUF_E * 2 + 512);
  if (!DIFF) {
    float q2 = 0.f;
#pragma unroll
    for (int ks = 0; ks < 4; ++ks)
#pragma unroll
      for (int e = 0; e < 8; ++e) { const float v = __uint_as_float(((unsigned)(unsigned short)qf[ks][e]) << 16); q2 += v * v; }
    q2 = xsum(q2);
    const float kmax2 = ((const float*)(ws + OFF_KMAX))[layer * 32 + b * 8 + head];
    qkb = sqrtf(q2 * kmax2) * 1.02f + 1.f;
  }
  const int kt0 = DIFF ? 0 : ntiles - 1;
  int wdone = 0;

  float rc = 0.f;
  ATT_ISSUE(kt0, 0)
  if (!DIFF && t < 64) rc = cumg[kt0 * 64 + t];
  asm volatile("s_waitcnt vmcnt(0)" ::: "memory");
  if (!DIFF && t < 64) scum[t] = rc;
  __syncthreads();

  for (int it = 0; it < ntiles; ++it) {
    const int kt = DIFF ? it : ntiles - 1 - it;
    const int kn = DIFF ? it + 1 : kt - 1;
    const bool has_next = (it + 1 < ntiles) && !(var & 1);
    const int buf = it & 1;
    if (has_next) {
      ATT_ISSUE(kn, buf ^ 1)
      if (!DIFF && t < 64) rc = cumg[kn * 64 + t];
    }
    const float* cb = scum + buf * 64;
    if (kt <= last_tile && !wdone && !(var & 2)) {
      const bf16_t* sV = sbase + buf * BUF_E + NK * KT_E;
      const bf16_t* sK = sbase + buf * BUF_E + cw * KT_E;
      if (!DIFF && kt >= 2 * qb) softmax_tile<DVB, !DIFF, true>(sK, sV, cb, qf, o, m, l, prow, r, h, kt * 64, qpos);
      else softmax_tile<DVB, !DIFF, false>(sK, sV, cb, qf, o, m, l, prow, r, h, kt * 64, qpos);
    }
    asm volatile("s_waitcnt vmcnt(0)" ::: "memory");
    if (has_next) {
      if (!DIFF && t < 64) scum[(buf ^ 1) * 64 + t] = rc;
    }
    if (!DIFF) {
      wdone = __all(qkb - cb[0] < m - 138.f);
      if (lane == 0) sflag[buf * 4 + w] = wdone;
    }
    __syncthreads();
    if (!DIFF) {
      if (sflag[buf * 4] & sflag[buf * 4 + 1] & sflag[buf * 4 + 2] & sflag[buf * 4 + 3]) break;
    }
  }
#undef ATT_ISSUE
  if (!DIFF) __syncthreads();

  const int tok = b * 4096 + qpos;
  bf16_t* gp = gbase + (size_t)tok * 1536;
  const float inv = 1.f / xsum(l);
  if (DIFF) {
    float* ex = (float*)smem;
    if (cw == 1) {
#pragma unroll
      for (int mb = 0; mb < DVB; ++mb)
#pragma unroll
        for (int e = 0; e < 16; ++e) ex[(((w & 1) * DVB + mb) * 16 + e) * 64 + lane] = o[mb][e] * inv;
    }
    __syncthreads();
    if (cw == 0) {
      const float* lv = p.dlam + layer * 256;
      float p1 = lv[lane] * lv[64 + lane], p2 = lv[128 + lane] * lv[192 + lane];
      p1 = wave_sum(p1); p2 = wave_sum(p2);
      const float lam_init = 0.2f + (float)layer * (0.6f - 0.6f * 0.74081822068171788f);
      const float lam = expf(p1) - expf(p2) + lam_init;
      float ss = 0.f;
#pragma unroll
      for (int mb = 0; mb < DVB; ++mb)
#pragma unroll
        for (int e = 0; e < 16; ++e) {
          const float v = o[mb][e] * inv - lam * ex[(((w & 1) * DVB + mb) * 16 + e) * 64 + lane];
          o[mb][e] = v;
          ss += v * v;
        }
      ss = xsum(ss);
      const float rn = rsqrtf(ss * (1.f / 128.f) + NORM_EPS) * (1.f - lam_init);
      const float* sg = p.subln + layer * 128;
#pragma unroll
      for (int mb = 0; mb < DVB; ++mb)
#pragma unroll
        for (int g = 0; g < 4; ++g) {
          const int dv = mb * 32 + 8 * g + 4 * h;
          bf16_t* a = gp + head * 128 + dv;
          const u32x2 gt = *(const u32x2*)a;
          const f32x4 gn = *(const f32x4*)(sg + dv);
          const float v0 = o[mb][4 * g] * rn * gn[0] * bflo(gt[0]);
          const float v1 = o[mb][4 * g + 1] * rn * gn[1] * bfhi(gt[0]);
          const float v2 = o[mb][4 * g + 2] * rn * gn[2] * bflo(gt[1]);
          const float v3 = o[mb][4 * g + 3] * rn * gn[3] * bfhi(gt[1]);
          u32x2 st = {pk2(v0, v1), pk2(v2, v3)};
          *(u32x2*)a = st;
        }
    }
    __syncthreads();
  } else {
#pragma unroll
    for (int mb = 0; mb < DVB; ++mb)
#pragma unroll
      for (int g = 0; g < 4; ++g) {
        const int dv = mb * 32 + 8 * g + 4 * h;
        bf16_t* a = gp + 1024 + head * 64 + dv;
        const u32x2 gt = *(const u32x2*)a;
        const float v0 = o[mb][4 * g] * inv * bflo(gt[0]);
        const float v1 = o[mb][4 * g + 1] * inv * bfhi(gt[0]);
        const float v2 = o[mb][4 * g + 2] * inv * bflo(gt[1]);
        const float v3 = o[mb][4 * g + 3] * inv * bfhi(gt[1]);
        u32x2 st = {pk2(v0, v1), pk2(v2, v3)};
        *(u32x2*)a = st;
      }
  }
}

template <bool DIAG>
DI void sb_weights(const f32x16& sc, float& carry, bf16x8& pf0, bf16x8& pf1, int sub, int h, int kbase, int qpos) {
  float beta[16], nb[16];
#pragma unroll
  for (int e = 0; e < 16; ++e) {
    const float u = __builtin_amdgcn_exp2f(sc[e]);
    const float rr = __builtin_amdgcn_rcpf(1.f + u);
    beta[e] = rr;
    nb[e] = 1.f - rr;
  }
  if (DIAG) {
#pragma unroll
    for (int e = 0; e < 16; ++e) {
      const int key = kbase + sub * 32 + (e >> 3) * 16 + 8 * h + (e & 7);
      if (key >= qpos) { beta[e] = 0.f; nb[e] = 1.f; }
    }
  }
  float E[16], Tt[2];
#pragma unroll
  for (int s2 = 0; s2 < 2; ++s2) {
    E[8 * s2 + 7] = 1.f;
#pragma unroll
    for (int j = 6; j >= 0; --j) E[8 * s2 + j] = E[8 * s2 + j + 1] * nb[8 * s2 + j + 1];
    Tt[s2] = E[8 * s2] * nb[8 * s2];
  }
  float T1l, T1h, T0l, T0h;
  xboth(Tt[1], T1l, T1h);
  xboth(Tt[0], T0l, T0h);
  const float c1 = carry * T1h;
  const float c2 = c1 * T1l;
  const float c3 = c2 * T0h;
  const float off1 = h ? carry : c1;
  const float off0 = h ? c2 : c3;
  carry = c3 * T0l;
  float a[16];
#pragma unroll
  for (int e = 0; e < 8; ++e) { a[e] = beta[e] * (E[e] * off0); a[8 + e] = beta[8 + e] * (E[8 + e] * off1); }
  pf0 = pack8(a[0], a[1], a[2], a[3], a[4], a[5], a[6], a[7]);
  pf1 = pack8(a[8], a[9], a[10], a[11], a[12], a[13], a[14], a[15]);
}

template <bool DIAG>
DI void sb_tile(const bf16_t* sK, const bf16_t* sV, const bf16x8 (&qf)[4], f32x16 (&o)[2], float& carry, int prow, int r, int h, int kbase, int qpos) {
  bf16x8 kf[2][4];
#pragma unroll
  for (int sub = 0; sub < 2; ++sub)
#pragma unroll
    for (int ks = 0; ks < 4; ++ks) kf[sub][ks] = *(const bf16x8*)((const char*)sK + (sub * 32 + prow) * 128 + (((2 * ks + h) ^ ((prow >> 1) & 7)) << 4));
  __builtin_amdgcn_sched_barrier(0);
  f32x16 sc[2];
#pragma unroll
  for (int sub = 0; sub < 2; ++sub) {
    f32x16 z;
#pragma unroll
    for (int e = 0; e < 16; ++e) z[e] = 0.f;
    sc[sub] = MFMA32(kf[sub][0], qf[0], z);
#pragma unroll
    for (int ks = 1; ks < 4; ++ks) sc[sub] = MFMA32(kf[sub][ks], qf[ks], sc[sub]);
  }
  bf16x8 vf[2][4];
#pragma unroll
  for (int mb = 0; mb < 2; ++mb)
#pragma unroll
    for (int f = 0; f < 4; ++f) vf[mb][f] = *(const bf16x8*)((const char*)sV + (mb * 32 + r) * 128 + (((2 * f + h) ^ ((r >> 1) & 7)) << 4));
  __builtin_amdgcn_sched_barrier(0);
  bf16x8 pf[4];
  sb_weights<DIAG>(sc[1], carry, pf[2], pf[3], 1, h, kbase, qpos);
  sb_weights<DIAG>(sc[0], carry, pf[0], pf[1], 0, h, kbase, qpos);
#pragma unroll
  for (int mb = 0; mb < 2; ++mb)
#pragma unroll
    for (int f = 0; f < 4; ++f) o[mb] = MFMA32(vf[mb][f], pf[f], o[mb]);
}

DI void attn_sb_item(const Params& p, int b, int head, int qb, char* smem, bf16_t* gbase) {
  constexpr int KT_E = 64 * 64, BUF_E = 2 * KT_E;
  unsigned char* ws = p.ws;
  bf16_t* sbase = (bf16_t*)smem;
  int* sflag = (int*)(smem + 40960);
  const int t = tid_opaque(), lane = t & 63, w = t >> 6, r = lane & 31, h = lane >> 5;
  const int wu = __builtin_amdgcn_readfirstlane(w);
  unsigned soff[2];
#pragma unroll
  for (int pp = 0; pp < 2; ++pp) soff[pp] = (unsigned)((8 * (pp * 4 + wu) + (lane >> 3)) * 128 + (((lane & 7) ^ (((wu & 1) << 2) + ((lane >> 4) & 3))) << 4));
#define SB_ISSUE(KT, BUF)                                                                                     \
  {                                                                                                           \
    char* d_ = smem + (BUF) * (BUF_E * 2) + wu * 1024;                                                        \
    _Pragma("unroll") for (int pp = 0; pp < 2; ++pp) {                                                        \
      glds16((const char*)(Kg + (size_t)(KT) * 64 * 64) + soff[pp], d_ + pp * 4096);                          \
      glds16((const char*)(Vg + (size_t)(KT) * 64 * 64) + soff[pp], d_ + KT_E * 2 + pp * 4096);               \
    }                                                                                                         \
  }
  const bf16_t* qkv = (const bf16_t*)(ws + OFF_QKV);
  const bf16_t* Qg = qkv + 3 * TENS + (size_t)(b * 8 + head) * 4096 * 64;
  const bf16_t* Kg = qkv + 4 * TENS + (size_t)(b * 8 + head) * 4096 * 64;
  const bf16_t* Vg = qkv + 5 * TENS + (size_t)(b * 8 + head) * 64 * 4096;
  const int q0 = qb * 128 + w * 32;
  const int qpos = q0 + r;
  bf16x8 qf[4];
#pragma unroll
  for (int ks = 0; ks < 4; ++ks) qf[ks] = *(const bf16x8*)(Qg + (size_t)qpos * 64 + ks * 16 + h * 8);
  f32x16 o[2];
#pragma unroll
  for (int mb = 0; mb < 2; ++mb)
#pragma unroll
    for (int e = 0; e < 16; ++e) o[mb][e] = 0.f;
  float carry = 1.f;
  const int ntiles = 2 * qb + 2;
  const int first_tile = 2 * qb + (w >> 1);
  const int prow = pi_row(r);

  SB_ISSUE(ntiles - 1, 0)
  asm volatile("s_waitcnt vmcnt(0)" ::: "memory");
  __syncthreads();

  for (int it = 0; it < ntiles; ++it) {
    const int kt = ntiles - 1 - it;
    const int buf = it & 1;
    if (kt > 0) SB_ISSUE(kt - 1, buf ^ 1)
    if (kt <= first_tile && !__all(carry < 0x1p-136f)) {
      const bf16_t* sK = sbase + buf * BUF_E;
      const bf16_t* sV = sK + KT_E;
      if (kt == first_tile) sb_tile<true>(sK, sV, qf, o, carry, prow, r, h, kt * 64, qpos);
      else sb_tile<false>(sK, sV, qf, o, carry, prow, r, h, kt * 64, qpos);
    }
    asm volatile("s_waitcnt vmcnt(0)" ::: "memory");
    const int wdone = __all(carry < 0x1p-136f);
    if (lane == 0) sflag[buf * 4 + w] = wdone;
    __syncthreads();
    if (sflag[buf * 4] & sflag[buf * 4 + 1] & sflag[buf * 4 + 2] & sflag[buf * 4 + 3]) break;
  }
#undef SB_ISSUE
  __syncthreads();
  const int tok = b * 4096 + qpos;
  bf16_t* gp = gbase + (size_t)tok * 1536 + 512 + head * 64;
#pragma unroll
  for (int mb = 0; mb < 2; ++mb)
#pragma unroll
    for (int g = 0; g < 4; ++g) {
      const int dv = mb * 32 + 8 * g + 4 * h;
      bf16_t* a = gp + dv;
      const u32x2 gt = *(const u32x2*)a;
      const float v0 = o[mb][4 * g] * bflo(gt[0]);
      const float v1 = o[mb][4 * g + 1] * bfhi(gt[0]);
      const float v2 = o[mb][4 * g + 2] * bflo(gt[1]);
      const float v3 = o[mb][4 * g + 3] * bfhi(gt[1]);
      u32x2 st = {pk2(v0, v1), pk2(v2, v3)};
      *(u32x2*)a = st;
    }
}

DI bool decode_item(int xq, int q, const float* __restrict__ fb, int& type, int& bh, int& qb) {
  if (q >= 16 && q < 144) { const int d = q - 16; type = 0; bh = 2 * xq + (d >> 6); qb = 63 - (d & 63); return true; }
  if (q < 256) {
    const int j = (q < 16) ? q : q - 128, want = j >> 5;
    const int h0 = (4 * xq) & 7;
    int pick = 0;
#pragma unroll
    for (int k = 0; k < 4; ++k) {
      int rank = 0;
#pragma unroll
      for (int k2 = 0; k2 < 4; ++k2) rank += (fb[h0 + k2] > fb[h0 + k] || (fb[h0 + k2] == fb[h0 + k] && k2 < k)) ? 1 : 0;
      if (rank == want) pick = k;
    }
    type = 2; bh = 4 * xq + pick; qb = 31 - (j & 31);
    return true;
  }
  if (q < 384) { const int j = q - 256; type = 1; bh = 4 * xq + (j & 3); qb = 31 - (j >> 2); return true; }
  return false;
}

#define XB_TMO      128
#define XB_XCNT(j)  (256  + 64 * (j))
#define XB_XSUB(j)  (1280 + 64 * (j))
#define XB_XGEN(j)  (2304 + 64 * (j))
#define XB_TOP      3328
#define XB_TOPGEN   3392
#define XCD_BAR_WORDS 3456
#define XB_SPIN_CAP (1u << 22)
#define LAS __attribute__((address_space(3)))
DI unsigned xb_ld(unsigned* p) { return __hip_atomic_load(p, __ATOMIC_RELAXED, __HIP_MEMORY_SCOPE_AGENT); }
DI unsigned xb_add(unsigned* p, unsigned v) { return __hip_atomic_fetch_add(p, v, __ATOMIC_RELAXED, __HIP_MEMORY_SCOPE_AGENT); }
DI unsigned xb_xcc_id() { return (unsigned)__builtin_amdgcn_s_getreg((3 << 11) | 20) & 0xFu; }
#define XB_SPIN(cond, bar) do { unsigned _sp = 0; while (cond) { __builtin_amdgcn_s_sleep(1); \
    if ((++_sp & 255u) == 0u) { if (xb_ld(&(bar)[XB_TMO])) break; if (_sp > XB_SPIN_CAP) { atomicAdd(&(bar)[XB_TMO], 1u); break; } } } } while (0)
struct XcdBarrier { unsigned* bar; unsigned x; volatile LAS unsigned* st; };
DI XcdBarrier xcd_barrier_post(unsigned* bar, volatile LAS unsigned* st) {
  XcdBarrier b; b.bar = bar; b.x = xb_xcc_id(); b.st = st;
  if (tid_opaque() == 0) (void)xb_add(&bar[XB_XCNT(b.x)], 1u);
  return b;
}
DI void xcd_barrier_complete(unsigned* bar, unsigned x, unsigned& nloc, unsigned& nx) {
  const unsigned G = gridDim.x * gridDim.y * gridDim.z;
  unsigned sum, cnt, mine, sp = 0u;
  for (;;) {
    sum = 0u; cnt = 0u; mine = 0u;
#pragma unroll
    for (unsigned j = 0; j < 16; ++j) { const unsigned c = xb_ld(&bar[XB_XCNT(j)]); sum += c; cnt += (c > 0u) ? 1u : 0u; mine = (j == x) ? c : mine; }
    if (sum == G) break;
    __builtin_amdgcn_s_sleep(1);
    if ((++sp & 255u) == 0u) { if (xb_ld(&bar[XB_TMO])) break; if (sp > XB_SPIN_CAP) { atomicAdd(&bar[XB_TMO], 1u); break; } }
  }
  nloc = mine > 0u ? mine : 1u; nx = cnt > 0u ? cnt : 1u;
}
DI void xcd_barrier_impl(const XcdBarrier& b) {
  asm volatile("s_waitcnt vmcnt(0)" ::: "memory");
  __syncthreads();
  if (tid_opaque() == 0) {
    unsigned* bar = b.bar;
    __builtin_amdgcn_s_waitcnt(0);
    unsigned nloc = b.st[0], nx = b.st[1];
    if (nloc == 0u) { xcd_barrier_complete(bar, b.x, nloc, nx); b.st[0] = nloc; b.st[1] = nx; }
    const unsigned old = xb_add(&bar[XB_XSUB(b.x)], 1u);
    const unsigned gen = old / nloc;
    if (old + 1u == (gen + 1u) * nloc) {
      __builtin_amdgcn_fence(__ATOMIC_RELEASE, "agent");
      asm volatile("s_waitcnt vmcnt(0)" ::: "memory");
      const unsigned og = xb_add(&bar[XB_TOP], 1u);
      const unsigned tg = og / nx;
      if (og + 1u == (tg + 1u) * nx) xb_add(&bar[XB_TOPGEN], 1u);
      else XB_SPIN(xb_ld(&bar[XB_TOPGEN]) == tg, bar);
      __builtin_amdgcn_fence(__ATOMIC_ACQUIRE, "agent");
      xb_add(&bar[XB_XGEN(b.x)], 1u);
      asm volatile("s_waitcnt vmcnt(0)" ::: "memory");
    } else {
      XB_SPIN(xb_ld(&bar[XB_XGEN(b.x)]) == gen, bar);
      __builtin_amdgcn_fence(__ATOMIC_ACQUIRE, "agent");
      asm volatile("s_waitcnt vmcnt(0)" ::: "memory");
    }
  }
  __syncthreads();
}
DI void xcd_barrier(const Params& p, volatile LAS unsigned* st) {
  XcdBarrier b; b.bar = (unsigned*)(p.ws + OFF_BAR); b.x = xb_xcc_id(); b.st = st;
  xcd_barrier_impl(b);
}

DI void phase_setup(const Params& p, char* smem) {
  unsigned char* ws = p.ws;
  const int nb = gridDim.x, bid = bid_opaque(), t = tid_opaque();
  if (bid == 0 && t < 64) { ((unsigned*)(ws + OFF_CTR))[t] = 0u; ((float*)(ws + OFF_KMAX))[t] = 0.f; }
  for (int e = bid * 256 + t; e < 4096 * 8; e += nb * 256) {
    const int s = e >> 3, i = e & 7;
    const float inv = powf(500000.0f, -(float)(2 * i) / 16.0f);
    const float ang = (float)s * inv;
    float sn, cs;
    sincosf(ang, &sn, &cs);
    ((float*)(ws + OFF_ROPE))[e] = cs;
    ((float*)(ws + OFF_ROPE))[4096 * 8 + e] = sn;
  }
  for (int it = bid; it < 1536; it += nb) {
    const int nblk = it % 96, kblk = it / 96;
    transpose_tile(p.w_in, DIN, (bf16_t*)(ws + OFF_WINT), 1024, kblk * 64, nblk * 64, smem);
  }
  stage_wf(p.w_in, smem);
  const int lane = t & 63, w = t >> 6;
#pragma unroll 1
  for (int row = bid * 4 + w; row < T; row += nb * 4) {
    f32x4 xv[4];
#pragma unroll
    for (int pp = 0; pp < 4; ++pp) xv[pp] = __builtin_nontemporal_load((const f32x4*)(p.x + (size_t)row * 1024 + 256 * pp + 4 * lane));
    prenorm_row(xv, p.gpre, (const float*)smem, p.fbias, (bf16_t*)(ws + OFF_H), (float*)(ws + OFF_LF), row, lane);
  }
  __syncthreads();
}

DI void phase_inproj(const Params& p, int layer, char* smem, int* s_item, const int var = 0) {
  unsigned char* ws = p.ws;
  for (int seq = blockIdx.x; seq < 32; seq += gridDim.x) cumsum_item((const float*)(ws + OFF_LF), (float*)(ws + OFF_CUM), seq, smem);
  if (var != 0) {
    for (int ti = blockIdx.x; ti < 64 * 48; ti += gridDim.x) {
      int mt, nt;
      tile_coords(ti, 8, mt, nt);
      inproj_tile(p, layer, mt, nt, smem, var);
    }
    return;
  }
  unsigned* ctr = (unsigned*)(ws + OFF_CTR) + 16 + layer * 8;
  const int home = (int)(xb_xcc_id() & 7u);
  const int t = tid_opaque();
  int cur = home, pend = 0;
  if (t == 0) pend = (int)atomicAdd(ctr + cur, 1u);
  for (;;) {
    if (t == 0) {
      int code = -1;
      for (;;) {
        if (pend < 384) { code = (cur << 16) | pend; break; }
        int best = 99, nxt = -1;
#pragma unroll
        for (int x = 0; x < 8; ++x) {
          const unsigned cx = xb_ld(ctr + x);
          const int d = (x - home) & 7;
          if (cx < 384u && d < best) { best = d; nxt = x; }
        }
        if (nxt < 0) break;
        cur = nxt;
        pend = (int)atomicAdd(ctr + cur, 1u);
      }
      *s_item = code;
    }
    __syncthreads();
    const int code = *s_item;
    __syncthreads();
    if (code < 0) break;
    if (t == 0) pend = (int)atomicAdd(ctr + cur, 1u);
    const int xq = code >> 16, q = code & 0xffff;
    const int ti = (5 - (q >> 6)) * 512 + (q & 63) * 8 + xq;
    int mt, nt;
    tile_coords(ti, 8, mt, nt);
    inproj_tile(p, layer, mt, nt, smem, 0);
  }
}

DI void phase_attn(const Params& p, int layer, char* smem, int* s_item, const int ctr_base = 0, const int type_mask = 7, bf16_t* gbase = nullptr, const int var = 0) {
  unsigned* ctr = (unsigned*)(p.ws + OFF_CTR) + ctr_base + layer * 8;
  if (gbase == nullptr) gbase = (bf16_t*)(p.ws + OFF_G);
  const int home = (int)(xb_xcc_id() & 7u);
  const int t = tid_opaque();
  int step = 0, pend = 0;
  if (t == 0) pend = (int)atomicAdd(ctr + (home & 7), 1u);
  for (;;) {
    if (t == 0) {
      int code = -1;
      while (step < 8) {
        if (pend < 384) { code = (((home + step) & 7) << 16) | pend; break; }
        ++step;
        if (step < 8) pend = (int)atomicAdd(ctr + ((home + step) & 7), 1u);
      }
      *s_item = code;
    }
    __syncthreads();
    const int code = *s_item;
    __syncthreads();
    if (code < 0) break;
    if (t == 0) pend = (int)atomicAdd(ctr + ((home + step) & 7), 1u);
    int type, bh, qb;
    if (!decode_item(code >> 16, code & 0xffff, p.fbias + layer * 8, type, bh, qb)) break;
    if (!((type_mask >> type) & 1)) continue;
    if (type == 0) attn_softmax_item<true>(p, layer, bh >> 2, bh & 3, qb, smem, gbase, var);
    else if (type == 1) attn_sb_item(p, bh >> 3, bh & 7, qb, smem, gbase);
    else attn_softmax_item<false>(p, layer, bh >> 3, bh & 7, qb, smem, gbase, var);
  }
  if (layer == 0 && ctr_base == 0) {
    unsigned* tctr = (unsigned*)(p.ws + OFF_CTR) + 60;
    for (;;) {
      if (t == 0) *s_item = (int)atomicAdd(tctr, 1u);
      __syncthreads();
      const int it = *s_item;
      __syncthreads();
      if (it >= 768 + 1536) break;
      if (it < 768) {
        const int lay = it / 384, jj = it % 384;
        const int nblk = jj % 16, kblk = jj / 16;
        transpose_tile(p.w_out + (size_t)lay * 1536 * 1024, 1024, (bf16_t*)(p.ws + OFF_WOUTT) + (size_t)lay * 1024 * 1536, 1536, kblk * 64, nblk * 64, smem);
      } else {
        const int j = it - 768;
        const int nblk = j % 96, kblk = j / 96;
        transpose_tile(p.w_in + (size_t)1024 * DIN, DIN, (bf16_t*)(p.ws + OFF_WINT), 1024, kblk * 64, nblk * 64, smem);
      }
    }
  }
}

DI void phase_outproj(const Params& p, int layer, char* smem) {
  for (int ti = blockIdx.x; ti < 64 * 8; ti += gridDim.x) {
    int mt, nt;
    tile_coords(ti, 8, mt, nt);
    outproj_tile(p, layer, mt, nt, smem);
  }
}

DI void phase_postnorm(const Params& p, int layer, char* smem) {
  unsigned char* ws = p.ws;
  const int t = tid_opaque(), lane = t & 63, w = t >> 6;
  if (layer == 0) stage_wf(p.w_in + (size_t)1024 * DIN, smem);
  const bf16_t* y = (const bf16_t*)(ws + OFF_QKV);
  const float* xin = (layer == 0) ? p.x : p.out;
  const float* gpost = p.gpost + layer * 1024;
#pragma unroll 1
  for (int row = blockIdx.x * 4 + w; row < T; row += gridDim.x * 4) {
    f32x4 yv[4], xv[4];
    float ss = 0.f;
#pragma unroll
    for (int pp = 0; pp < 4; ++pp) {
      const u32x2 yb = __builtin_nontemporal_load((const u32x2*)(y + (size_t)row * 1024 + 256 * pp + 4 * lane));
      yv[pp][0] = bflo(yb[0]); yv[pp][1] = bfhi(yb[0]); yv[pp][2] = bflo(yb[1]); yv[pp][3] = bfhi(yb[1]);
      xv[pp] = __builtin_nontemporal_load((const f32x4*)(xin + (size_t)row * 1024 + 256 * pp + 4 * lane));
#pragma unroll
      for (int i = 0; i < 4; ++i) ss += yv[pp][i] * yv[pp][i];
    }
    ss = wave_sum(ss);
    const float rinv = rsqrtf(ss * (1.f / 1024.f) + NORM_EPS);
#pragma unroll
    for (int pp = 0; pp < 4; ++pp) {
      const f32x4 g = *(const f32x4*)(gpost + 256 * pp + 4 * lane);
#pragma unroll
      for (int i = 0; i < 4; ++i) xv[pp][i] += yv[pp][i] * rinv * g[i];
      *(f32x4*)(p.out + (size_t)row * 1024 + 256 * pp + 4 * lane) = xv[pp];
    }
    if (layer == 0)
      prenorm_row(xv, p.gpre + 1024, (const float*)smem, p.fbias + 8, (bf16_t*)(ws + OFF_H), (float*)(ws + OFF_LF), row, lane);
  }
  __syncthreads();
}

__global__ void __launch_bounds__(256, 2) fwd_kernel(Params p) {
  __shared__ __attribute__((aligned(1024))) char smem[SMEM_BYTES];
  __shared__ uint4 xb_words;
  __shared__ int s_item;
  if (tid_opaque() == 0) xb_words = make_uint4(0u, 0u, 0u, 0u);
  __syncthreads();
  (void)xcd_barrier_post((unsigned*)(p.ws + OFF_BAR), (volatile LAS unsigned*)&xb_words);
  if (p.ws == nullptr) cg::this_grid().sync();
  for (int rep = 0; rep < (DUP_PHASE == 0 ? 2 : 1); ++rep) { phase_setup(p, smem); xcd_barrier(p, (volatile LAS unsigned*)&xb_words); }
#pragma unroll 1
  for (int layer = 0; layer < 2; ++layer) {
    for (int rep = 0; rep < (DUP_PHASE == 1 ? 2 - layer : 1); ++rep) { phase_inproj(p, layer, smem, &s_item, rep ? EXP_VAR : 0); xcd_barrier(p, (volatile LAS unsigned*)&xb_words); }
    phase_attn(p, layer, smem, &s_item);
    xcd_barrier(p, (volatile LAS unsigned*)&xb_words);
    if (DUP_PHASE == 2 && layer == 0) { phase_attn(p, layer, smem, &s_item, 32, EXP_VAR & 7, (bf16_t*)p.out, EXP_VAR >> 3); xcd_barrier(p, (volatile LAS unsigned*)&xb_words); }
    for (int rep = 0; rep < (DUP_PHASE == 3 ? 2 - layer : 1); ++rep) { phase_outproj(p, layer, smem); xcd_barrier(p, (volatile LAS unsigned*)&xb_words); }
    for (int rep = 0; rep < (DUP_PHASE == 4 ? 2 - layer : 1); ++rep) { phase_postnorm(p, layer, smem); if (layer == 0) xcd_barrier(p, (volatile LAS unsigned*)&xb_words); }
  }
}

extern "C" void kernel_launch(void* const* d_in, const int* in_sizes, int n_in, void* d_out, int out_size, void* d_ws, size_t ws_size,
                              hipStream_t stream) {
  static int grid_blocks = 0;
  if (!grid_blocks) {
    int dev = 0, cus = 0, per_cu = 0;
    (void)hipGetDevice(&dev);
    (void)hipDeviceGetAttribute(&cus, hipDeviceAttributeMultiprocessorCount, dev);
    (void)hipOccupancyMaxActiveBlocksPerMultiprocessor(&per_cu, fwd_kernel, 256, 0);
    if (per_cu > 2) per_cu = 2;
    if (per_cu < 1) per_cu = 1;
    grid_blocks = cus * per_cu;
    if (ws_size < WS_NEED) fprintf(stderr, "workspace too small: %zu < %zu\n", ws_size, WS_NEED);
  }
  Params p{};
  p.x = (const float*)d_in[0]; p.w_in = (const float*)d_in[1]; p.fbias = (const float*)d_in[2]; p.dlam = (const float*)d_in[3];
  p.subln = (const float*)d_in[4]; p.w_out = (const float*)d_in[5]; p.gpre = (const float*)d_in[6]; p.gpost = (const float*)d_in[7];
  p.out = (float*)d_out; p.ws = (unsigned char*)d_ws;
  (void)hipMemsetAsync((unsigned char*)d_ws + OFF_BAR, 0, XCD_BAR_WORDS * 4, stream);
  void* args[] = {&p};
  hipError_t e = hipLaunchCooperativeKernel((void*)fwd_kernel, dim3(grid_blocks), dim3(256), args, 0, stream);
  if (e != hipSuccess) fprintf(stderr, "cooperative launch failed: %s (grid %d)\n", hipGetErrorString(e), grid_blocks);
}
```
